# Optimizing an MI355X kernel written in HIP

```python
import jax, jax.numpy as jnp
from jax import lax
import numpy as np

D_MODEL = 1024
BATCH = 32
SEQ = 2048
DEPTH = 2

N_A_LAYERS = DEPTH // 2
N_B_LAYERS = DEPTH - N_A_LAYERS

NORM_EPS = 1e-6

A_WINDOWS = (128, 512, 2048)
A_DILATIONS = (1, 4, 16)
A_GROUPS = 3
A_HEADS = 8
A_HEAD_DIM = 128
A_WIDTH = A_HEADS * A_HEAD_DIM
A_ROT_DIM = A_HEAD_DIM // 4
A_ROPE_THETA = 500000.0
BAND_BLOCK = 128
A_IN_WIDTH = A_GROUPS * 3 * A_WIDTH + A_WIDTH

B_HEADS = 16
B_NOPE = 64
B_ROPE = 32
B_QK_DIM = B_NOPE + B_ROPE
B_VDIM = 64
B_WIDTH = B_HEADS * B_VDIM
B_Q_LORA = 384
B_KV_LORA = 256
B_ROPE_THETA = 10000.0
B_IN_WIDTH = B_Q_LORA + B_WIDTH
ATTN_BLOCK = 128

kernel_name = "yoco_dilated_swa_mla_hybrid"


def rms_norm(x, g):
    xf = x.astype(jnp.float32)
    y = xf * lax.rsqrt(jnp.mean(xf * xf, axis=-1, keepdims=True) + NORM_EPS)
    return (y * g.astype(jnp.float32)).astype(x.dtype)


def rope(x, positions, theta):
    dim = x.shape[-1]
    half = dim // 2
    inv_freq = 1.0 / (theta ** (jnp.arange(half, dtype=jnp.float32) * (2.0 / dim)))
    ang = positions.astype(jnp.float32)[..., None] * inv_freq
    cos = jnp.cos(ang)[:, :, None, :]
    sin = jnp.sin(ang)[:, :, None, :]
    xf = x.astype(jnp.float32)
    x1, x2 = xf[..., :half], xf[..., half:]
    out = jnp.concatenate([x1 * cos - x2 * sin, x2 * cos + x1 * sin], axis=-1)
    return out.astype(x.dtype)


def partial_rope(x, positions):
    return jnp.concatenate(
        [rope(x[..., :A_ROT_DIM], positions, A_ROPE_THETA), x[..., A_ROT_DIM:]], axis=-1)


def dilated_window_attention(q, k, v, window, dilation):
    B, T, H, Dh = q.shape
    L = T // dilation
    w_sub = window // dilation
    Q = BAND_BLOCK
    nb = -(-L // Q)
    Lp = nb * Q

    def split(a):
        a = a.reshape(B, L, dilation, H, Dh).transpose(0, 2, 1, 3, 4)
        a = jnp.pad(a, ((0, 0), (0, 0), (0, Lp - L), (0, 0), (0, 0)))
        return a.reshape(B, dilation, nb, Q, H, Dh)

    def band(a):
        prev = jnp.pad(a, ((0, 0), (0, 0), (1, 0), (0, 0), (0, 0), (0, 0)))[:, :, :-1]
        return jnp.concatenate([prev, a], axis=3)

    qb = split(q)
    kb = band(split(k))
    vb = band(split(v))
    s = jnp.einsum('brnqhd,brnkhd->brnhqk', qb, kb,
                   preferred_element_type=jnp.float32) * (A_HEAD_DIM ** -0.5)
    qi = jnp.arange(Q)[:, None]
    ki = jnp.arange(2 * Q)[None, :]
    dist = Q + qi - ki
    key_pos = (jnp.arange(nb)[:, None, None] - 1) * Q + ki[None]
    allowed = (dist >= 0)[None] & (dist <= w_sub)[None] & (key_pos >= 0)
    s = jnp.where(allowed[None, None, :, None], s, -jnp.inf)
    m = jnp.max(s, axis=-1, keepdims=True)
    p = jnp.exp(s - m)
    l = jnp.sum(p, axis=-1)
    o = jnp.einsum('brnhqk,brnkhd->brnqhd', p, vb.astype(jnp.float32))
    l_q = l.transpose(0, 1, 2, 4, 3)
    o = o / l_q[..., None]
    lse = (m[..., 0] + jnp.log(l)).transpose(0, 1, 2, 4, 3)
    o = o.reshape(B, dilation, Lp, H, Dh)[:, :, :L].transpose(0, 2, 1, 3, 4).reshape(B, T, H, Dh)
    lse = lse.reshape(B, dilation, Lp, H)[:, :, :L].transpose(0, 2, 1, 3).reshape(B, T, H)
    return o, lse


def mixer_a(h, positions, w_in, w_out):
    B, T, _ = h.shape
    proj = h @ w_in
    qkv = proj[..., :A_GROUPS * 3 * A_WIDTH].reshape(B, T, A_GROUPS, 3, A_HEADS, A_HEAD_DIM)
    z = proj[..., A_GROUPS * 3 * A_WIDTH:]
    outs, lses = [], []
    for g in range(A_GROUPS):
        q = partial_rope(qkv[:, :, g, 0], positions)
        k = partial_rope(qkv[:, :, g, 1], positions)
        v = qkv[:, :, g, 2]
        o, lse = dilated_window_attention(q, k, v, A_WINDOWS[g], A_DILATIONS[g])
        outs.append(o)
        lses.append(lse)
    wts = jax.nn.softmax(jnp.stack(lses, axis=0), axis=0)
    o = jnp.einsum('gbth,gbthd->bthd', wts, jnp.stack(outs, axis=0))
    y = o.reshape(B, T, A_WIDTH).astype(h.dtype) * jax.nn.silu(z)
    return y @ w_out


def shared_latent_kv(h, positions, kv_norm, kv_w_down, kv_latent_norm, kv_w_up):
    B, T, _ = h.shape
    hn = rms_norm(h, kv_norm)
    ckr = hn @ kv_w_down
    c_kv = rms_norm(ckr[..., :B_KV_LORA], kv_latent_norm)
    k_rope = rope(ckr[..., B_KV_LORA:][:, :, None, :], positions, B_ROPE_THETA)
    kv = (c_kv @ kv_w_up).reshape(B, T, B_HEADS, B_NOPE + B_VDIM)
    k = jnp.concatenate(
        [kv[..., :B_NOPE], jnp.broadcast_to(k_rope, (B, T, B_HEADS, B_ROPE))], axis=-1)
    v = kv[..., B_NOPE:]
    return k, v


def causal_block_attention(q, k, v):
    B, T, H, Dq = q.shape
    Dv = v.shape[-1]
    nb = T // ATTN_BLOCK
    q_blocks = q.reshape(B, nb, ATTN_BLOCK, H, Dq).transpose(1, 0, 2, 3, 4)
    k_pos = jnp.arange(T)
    vf = v.astype(jnp.float32)

    def one_block(args):
        qb, idx = args
        s = jnp.einsum('bqhd,bkhd->bhqk', qb, k,
                       preferred_element_type=jnp.float32) * (B_QK_DIM ** -0.5)
        q_pos = idx * ATTN_BLOCK + jnp.arange(ATTN_BLOCK)
        mask = k_pos[None, :] <= q_pos[:, None]
        p = jax.nn.softmax(jnp.where(mask[None, None], s, -jnp.inf), axis=-1)
        return jnp.einsum('bhqk,bkhd->bqhd', p, vf)

    o = lax.map(one_block, (q_blocks, jnp.arange(nb)))
    return o.transpose(1, 0, 2, 3, 4).reshape(B, T, H, Dv)


def mixer_b(h, positions, k, v, w_in, q_norm, w_q_up, w_out):
    B, T, _ = h.shape
    proj = h @ w_in
    c_q = rms_norm(proj[..., :B_Q_LORA], q_norm)
    z = proj[..., B_Q_LORA:]
    q = (c_q @ w_q_up).reshape(B, T, B_HEADS, B_QK_DIM)
    q = jnp.concatenate([q[..., :B_NOPE], rope(q[..., B_NOPE:], positions, B_ROPE_THETA)], axis=-1)
    o = causal_block_attention(q, k, v)
    y = o.reshape(B, T, B_WIDTH).astype(h.dtype) * jax.nn.silu(z)
    return y @ w_out


def setup_inputs(seed: int = 0) -> dict:
    key = jax.random.key(seed)
    ks = jax.random.split(key, 20)
    f32 = jnp.float32

    def w(k, shape, fan_in):
        return jax.random.normal(k, shape, f32) * (fan_in ** -0.5)

    def gain(k, shape):
        return 1.0 + 0.01 * jax.random.normal(k, shape, f32)

    x = jax.random.normal(ks[0], (BATCH, SEQ, D_MODEL), f32)
    offsets = jax.random.randint(ks[1], (BATCH, 1), 0, 4096, dtype=jnp.int32)
    positions = offsets + jnp.arange(SEQ, dtype=jnp.int32)[None, :]
    return {
        "x": x,
        "positions": positions,
        "a_pre_norm": gain(ks[2], (N_A_LAYERS, D_MODEL)),
        "a_w_in": w(ks[3], (N_A_LAYERS, D_MODEL, A_IN_WIDTH), D_MODEL),
        "a_w_out": w(ks[4], (N_A_LAYERS, A_WIDTH, D_MODEL), A_WIDTH),
        "a_post_norm": gain(ks[5], (N_A_LAYERS, D_MODEL)),
        "kv_norm": gain(ks[6], (D_MODEL,)),
        "kv_w_down": w(ks[7], (D_MODEL, B_KV_LORA + B_ROPE), D_MODEL),
        "kv_latent_norm": gain(ks[8], (B_KV_LORA,)),
        "kv_w_up": w(ks[9], (B_KV_LORA, B_HEADS * (B_NOPE + B_VDIM)), B_KV_LORA),
        "b_pre_norm": gain(ks[10], (N_B_LAYERS, D_MODEL)),
        "b_w_in": w(ks[11], (N_B_LAYERS, D_MODEL, B_IN_WIDTH), D_MODEL),
        "b_q_norm": gain(ks[12], (N_B_LAYERS, B_Q_LORA)),
        "b_w_q_up": w(ks[13], (N_B_LAYERS, B_Q_LORA, B_HEADS * B_QK_DIM), B_Q_LORA),
        "b_w_out": w(ks[14], (N_B_LAYERS, B_WIDTH, D_MODEL), B_WIDTH),
        "b_post_norm": gain(ks[15], (N_B_LAYERS, D_MODEL)),
    }


def reference(x, positions, a_pre_norm, a_w_in, a_w_out, a_post_norm,
              kv_norm, kv_w_down, kv_latent_norm, kv_w_up,
              b_pre_norm, b_w_in, b_q_norm, b_w_q_up, b_w_out, b_post_norm):
    h = x
    k_shared = None
    v_shared = None
    for layer in range(DEPTH):
        if layer < N_A_LAYERS:
            i = layer
            y = mixer_a(rms_norm(h, a_pre_norm[i]), positions, a_w_in[i], a_w_out[i])
            h = h + rms_norm(y, a_post_norm[i])
        else:
            if layer == N_A_LAYERS:
                k_shared, v_shared = shared_latent_kv(
                    h, positions, kv_norm, kv_w_down, kv_latent_norm, kv_w_up)
            i = layer - N_A_LAYERS
            y = mixer_b(rms_norm(h, b_pre_norm[i]), positions, k_shared, v_shared,
                        b_w_in[i], b_q_norm[i], b_w_q_up[i], b_w_out[i])
            h = h + rms_norm(y, b_post_norm[i])
    return h
```

```cpp
#include <hip/hip_runtime.h>
#include <hip/hip_cooperative_groups.h>
#include <cstdint>
#include <cstdio>
namespace cg = cooperative_groups;

#define DI __device__ __forceinline__
#define LAS __attribute__((address_space(3)))
typedef unsigned short bf16_t;
typedef short bf16x8 __attribute__((ext_vector_type(8)));
typedef float f32x16 __attribute__((ext_vector_type(16)));
typedef float f32x4 __attribute__((ext_vector_type(4)));
typedef float f32x2 __attribute__((ext_vector_type(2)));
typedef unsigned u32x4 __attribute__((ext_vector_type(4)));
typedef unsigned u32x2 __attribute__((ext_vector_type(2)));
typedef __bf16 bfv2 __attribute__((ext_vector_type(2)));

#define MFMA(a, b, c) __builtin_amdgcn_mfma_f32_32x32x16_bf16((a), (b), (c), 0, 0, 0)

constexpr int T_SEQ = 2048;
constexpr int DM = 1024;
constexpr int NBATCH = 32;
constexpr float QSCALE_A = 0.08838834764831845f * 1.4426950408889634f;
constexpr float QSCALE_B = 0.10206207261596575f * 1.4426950408889634f;
constexpr float LOG2E = 1.4426950408889634f;
constexpr float EPS = 1e-6f;

constexpr int TS = 144;
constexpr int TILE_BYTES = 256 * TS;
constexpr int CS = 528;
constexpr int CSH = 272;
constexpr int NTHR = 512;
constexpr int SMEM_BYTES = 4 * (64 * 272 + 128 * 144);

struct Params {
    const float* x; const int* pos; const float* a_pre; const float* a_w_in; const float* a_w_out; const float* a_post;
    const float* kv_norm; const float* kv_w_down; const float* kv_lat; const float* kv_w_up;
    const float* b_pre; const float* b_w_in; const float* b_qn; const float* b_w_q_up; const float* b_w_out; const float* b_post;
    float* out;
    unsigned* bar;
    bf16_t *WaT, *WaoT, *WdT, *WkvuT, *WquT, *WboT;
    float *cosA, *sinA, *cosB, *sinB;
    bf16_t *hn0, *Za, *Oa; float* La;
    bf16_t *Qa, *Ka, *VaT;
    bf16_t *hn1, *y2, *yB, *ckr, *cq, *zb, *ckvn, *cqn, *Kb, *VbT, *Qb, *krope; float* ssq;
    int CB; int nchunks; int magic; int pad;
};

struct KParams {
    const float* x; const int* pos; const float* a_pre; const float* a_w_in; const float* a_w_out; const float* a_post;
    const float* kv_norm; const float* kv_w_down; const float* kv_lat; const float* kv_w_up;
    const float* b_pre; const float* b_w_in; const float* b_qn; const float* b_w_q_up; const float* b_w_out; const float* b_post;
    float* out;
    unsigned* bar;
    bf16_t* wbase; float* tbase; bf16_t* abase; bf16_t* rbase;
    int CB; int nchunks; int magic; int pad;
};
__device__ __forceinline__ Params derive(const KParams& k) {
    Params p;
    p.x = k.x; p.pos = k.pos; p.a_pre = k.a_pre; p.a_w_in = k.a_w_in; p.a_w_out = k.a_w_out; p.a_post = k.a_post;
    p.kv_norm = k.kv_norm; p.kv_w_down = k.kv_w_down; p.kv_lat = k.kv_lat; p.kv_w_up = k.kv_w_up;
    p.b_pre = k.b_pre; p.b_w_in = k.b_w_in; p.b_qn = k.b_qn; p.b_w_q_up = k.b_w_q_up; p.b_w_out = k.b_w_out; p.b_post = k.b_post;
    p.out = k.out; p.bar = k.bar;
    long NT = (long)k.CB * 2048;
    asm volatile("" : "+s"(NT));
    p.WaT = k.wbase; p.WaoT = p.WaT + 10240L * 1024; p.WdT = p.WaoT + 1024L * 1024; p.WkvuT = p.WdT + 1792L * 1024; p.WquT = p.WkvuT + 2048L * 256; p.WboT = p.WquT + 1536L * 384;
    p.cosA = k.tbase; p.sinA = p.cosA + NT * 16; p.cosB = p.cosA + NT * 32; p.sinB = p.cosA + NT * 48;
    p.hn0 = k.abase; p.Za = p.hn0 + NT * 1024; p.Oa = p.hn0 + NT * 2048; p.La = (float*)(p.hn0 + NT * 5120);
    p.Qa = k.rbase; p.Ka = p.Qa + NT * 3072; p.VaT = p.Qa + NT * 6144;
    p.hn1 = k.rbase; p.y2 = p.hn1; p.yB = p.hn1 + NT * 1024; p.ckr = p.hn1 + NT * 2048; p.cq = p.hn1 + NT * 2336; p.zb = p.hn1 + NT * 2720;
    p.ckvn = p.hn1 + NT * 3744; p.cqn = p.hn1 + NT * 4000; p.Kb = p.hn1 + NT * 4384; p.VbT = p.hn1 + NT * 5920; p.Qb = p.hn1 + NT * 6944;
    p.krope = p.hn1 + NT * 8480; p.ssq = (float*)(p.hn1 + NT * 8512);
    p.CB = k.CB; p.nchunks = k.nchunks; p.magic = k.magic; p.pad = 0;
    return p;
}

DI unsigned pk2(float lo, float hi) { f32x2 v = {lo, hi}; bfv2 b = __builtin_convertvector(v, bfv2); return __builtin_bit_cast(unsigned, b); }
DI float bflo(unsigned u) { return __uint_as_float(u << 16); }
DI float bfhi(unsigned u) { return __uint_as_float(u & 0xffff0000u); }
DI unsigned short f2bf(float x) { return (unsigned short)(pk2(x, 0.f) & 0xffffu); }
DI float wave_sum(float v) {
#pragma unroll
    for (int o = 32; o > 0; o >>= 1) v += __shfl_xor(v, o);
    return v;
}
DI int tid() { int t = threadIdx.x; asm volatile("" : "+v"(t)); return t; }
DI int bidx() { int b = blockIdx.x; asm volatile("" : "+s"(b)); return b; }
DI float fexp2(float x) { return __builtin_amdgcn_exp2f(x); }
DI float silu(float z) { const float e = fexp2(-z * LOG2E); return z * __builtin_amdgcn_rcpf(1.0f + e); }
DI void unpack8(const u32x4& v, float (&f)[8]) {
    f[0] = bflo(v.x); f[1] = bfhi(v.x); f[2] = bflo(v.y); f[3] = bfhi(v.y); f[4] = bflo(v.z); f[5] = bfhi(v.z); f[6] = bflo(v.w); f[7] = bfhi(v.w);
}
DI u32x4 pack8(const float (&f)[8]) { u32x4 v; v.x = pk2(f[0], f[1]); v.y = pk2(f[2], f[3]); v.z = pk2(f[4], f[5]); v.w = pk2(f[6], f[7]); return v; }

#define XB_TMO      128
#define XB_XCNT(j)  (256  + 64 * (j))
#define XB_XSUB(j)  (1280 + 64 * (j))
#define XB_XGEN(j)  (2304 + 64 * (j))
#define XB_TOP      3328
#define XB_TOPGEN   3392
#define XCD_BAR_WORDS 3456
#define XB_SPIN_CAP (1u << 22)
DI unsigned xb_ld(unsigned* p)              { return __hip_atomic_load(p, __ATOMIC_RELAXED, __HIP_MEMORY_SCOPE_AGENT); }
DI unsigned xb_add(unsigned* p, unsigned v) { return __hip_atomic_fetch_add(p, v, __ATOMIC_RELAXED, __HIP_MEMORY_SCOPE_AGENT); }
DI unsigned xb_xcc_id() { return (unsigned)__builtin_amdgcn_s_getreg((3 << 11) | 20) & 0xFu; }
#define XB_SPIN(cond, bar) do { unsigned _sp = 0; while (cond) { __builtin_amdgcn_s_sleep(1); \
    if ((++_sp & 255u) == 0u) { if (xb_ld(&(bar)[XB_TMO])) break; if (_sp > XB_SPIN_CAP) { atomicAdd(&(bar)[XB_TMO], 1u); break; } } } } while (0)
struct XcdBarrier { unsigned* bar; unsigned x; volatile LAS unsigned* st; };
DI XcdBarrier xcd_barrier_post(unsigned* bar, volatile LAS unsigned* st) {
    XcdBarrier b; b.bar = bar; b.x = xb_xcc_id(); b.st = st;
    if (threadIdx.x == 0) (void)xb_add(&bar[XB_XCNT(b.x)], 1u);
    return b;
}
DI void xcd_barrier_complete(unsigned* bar, unsigned x, unsigned& nloc, unsigned& nx) {
    const unsigned G = gridDim.x * gridDim.y * gridDim.z;
    unsigned sum, cnt, mine, sp = 0u;
    for (;;) {
        sum = 0u; cnt = 0u; mine = 0u;
#pragma unroll
        for (unsigned j = 0; j < 16; ++j) { const unsigned c = xb_ld(&bar[XB_XCNT(j)]); sum += c; cnt += (c > 0u) ? 1u : 0u; mine = (j == x) ? c : mine; }
        if (sum == G) break;
        __builtin_amdgcn_s_sleep(1);
        if ((++sp & 255u) == 0u) { if (xb_ld(&bar[XB_TMO])) break; if (sp > XB_SPIN_CAP) { atomicAdd(&bar[XB_TMO], 1u); break; } }
    }
    nloc = mine > 0u ? mine : 1u; nx = cnt > 0u ? cnt : 1u;
}
DI void xcd_barrier(const XcdBarrier& b) {
    asm volatile("s_waitcnt vmcnt(0)" ::: "memory");
    __syncthreads();
    if (threadIdx.x == 0) {
        unsigned* bar = b.bar;
        __builtin_amdgcn_s_waitcnt(0);
        unsigned nloc = b.st[0], nx = b.st[1];
        if (nloc == 0u) { xcd_barrier_complete(bar, b.x, nloc, nx); b.st[0] = nloc; b.st[1] = nx; }
        const unsigned old = xb_add(&bar[XB_XSUB(b.x)], 1u);
        const unsigned gen = old / nloc;
        if (old + 1u == (gen + 1u) * nloc) {
            __builtin_amdgcn_fence(__ATOMIC_RELEASE, "agent");
            asm volatile("s_waitcnt vmcnt(0)" ::: "memory");
            const unsigned og = xb_add(&bar[XB_TOP], 1u);
            const unsigned tg = og / nx;
            if (og + 1u == (tg + 1u) * nx) xb_add(&bar[XB_TOPGEN], 1u);
            else XB_SPIN(xb_ld(&bar[XB_TOPGEN]) == tg, bar);
            __builtin_amdgcn_fence(__ATOMIC_ACQUIRE, "agent");
            xb_add(&bar[XB_XGEN(b.x)], 1u);
            asm volatile("s_waitcnt vmcnt(0)" ::: "memory");
        } else {
            XB_SPIN(xb_ld(&bar[XB_XGEN(b.x)]) == gen, bar);
            __builtin_amdgcn_fence(__ATOMIC_ACQUIRE, "agent");
            asm volatile("s_waitcnt vmcnt(0)" ::: "memory");
        }
    }
    __syncthreads();
}

DI void transpose_weight(const float* __restrict__ W, bf16_t* __restrict__ WT, int K, int N, int Npad, const float* __restrict__ gain, char* smem) {
    float (*Tl)[33] = (float (*)[33])smem;
    const int t = tid();
    const int ntk = K >> 6, ntn = Npad >> 5, ntiles = ntk * ntn;
    for (int tile = bidx(); tile < ntiles; tile += gridDim.x) {
        const int kt = tile % ntk, nt = tile / ntk;
        const int k0 = kt << 6, n0 = nt << 5;
        __syncthreads();
        if (t < 256) {
#pragma unroll
            for (int i = 0; i < 2; ++i) {
                const int k = (t >> 3) + 32 * i, n = 4 * (t & 7);
                f32x4 v = {0.f, 0.f, 0.f, 0.f};
                if (n0 + n < N) v = *(const f32x4*)(W + (long)(k0 + k) * N + n0 + n);
                const float gk = gain ? gain[k0 + k] : 1.0f;
                Tl[k][n] = v.x * gk; Tl[k][n + 1] = v.y * gk; Tl[k][n + 2] = v.z * gk; Tl[k][n + 3] = v.w * gk;
            }
        }
        __syncthreads();
        if (t < 256) {
            const int n = t >> 3, c = t & 7;
            float f[8];
#pragma unroll
            for (int j = 0; j < 8; ++j) f[j] = Tl[8 * c + j][n];
            *(u32x4*)(WT + (long)(n0 + n) * K + k0 + 8 * c) = pack8(f);
        }
    }
}

DI int lds_byte(int r, int c) { const int st = (r >> 4) * 2 + (c >> 5), rr = r & 15, cc = c & 31, ob = rr * 64 + cc * 2; return st * 1024 + (ob ^ (((ob >> 9) & 1) << 5)); }
DI void stage_rc(int b, int& R, int& C) { const int st = b / 1024, sb = b % 1024, swz = sb ^ (((sb >> 9) & 1) << 5); R = (st >> 1) * 16 + swz / 64; C = (st & 1) * 32 + (swz % 64) / 2; }
#define GLDS(gp, lp) __builtin_amdgcn_global_load_lds((const unsigned*)(gp), (LAS unsigned*)(lp), 16, 0, 0)
#define HTB 16384
DI void gemm_mainloop(const bf16_t* __restrict__ a0, long aoff1, long aoff2, long aoff3,
                      const bf16_t* __restrict__ bp, long b_stride, int K, char* smem, f32x4 (&acc)[2][2][4][2]) {
    const int t = tid(), lane = t & 63, wid = t >> 6, wr = wid >> 2, wc = wid & 3, fr = lane & 15, fq = lane >> 4;
    LAS char* sl = (LAS char*)smem;
    LAS char* lw = sl + t * 16;
    const int intra = (fr * 64 + fq * 16) ^ ((fr >> 3) << 5);
    const LAS char* ra = sl + wr * 8192 + intra;
    const LAS char* rb = sl + 4 * HTB + wc * 4096 + intra;
#define LAUNDER_OFFS asm volatile("" : "+s"(aoff1), "+s"(aoff2), "+s"(aoff3), "+s"(b_stride))
#define STAGE_A(b, h, kt) do { const long _ko = (long)(kt) * 64; GLDS(a0 + (((h) ? aoff2 : 0L) + _ko), lw + ((b) * 2 + (h)) * HTB); GLDS(a0 + (((h) ? aoff3 : aoff1) + _ko), lw + ((b) * 2 + (h)) * HTB + 8192); } while (0)
#define STAGE_B(b, h, kt) do { const long _ko = (long)(kt) * 64 + (long)((h) * 128) * b_stride; GLDS(bp + _ko, lw + (4 + (b) * 2 + (h)) * HTB); GLDS(bp + (_ko + 64 * b_stride), lw + (4 + (b) * 2 + (h)) * HTB + 8192); } while (0)
#define LDA(dst, b, h) _Pragma("unroll") for (int m = 0; m < 4; ++m) _Pragma("unroll") for (int k = 0; k < 2; ++k) dst[m][k] = *(const LAS bf16x8*)(ra + ((b) * 2 + (h)) * HTB + m * 2048 + k * 1024)
#define LDB(dst, b, h) _Pragma("unroll") for (int n = 0; n < 2; ++n) _Pragma("unroll") for (int k = 0; k < 2; ++k) dst[n][k] = *(const LAS bf16x8*)(rb + ((b) * 2 + (h)) * HTB + n * 2048 + k * 1024)
#define MMA(ai, bj, At, Bt) do { __builtin_amdgcn_s_setprio(1); \
    _Pragma("unroll") for (int m = 0; m < 4; ++m) _Pragma("unroll") for (int n = 0; n < 2; ++n) _Pragma("unroll") for (int k = 0; k < 2; ++k) \
        acc[ai][bj][m][n] = __builtin_amdgcn_mfma_f32_16x16x32_bf16(Bt[n][k], At[m][k], acc[ai][bj][m][n], 0, 0, 0); \
    __builtin_amdgcn_s_setprio(0); } while (0)
#define WAIT_V(n) asm volatile("s_waitcnt vmcnt(" #n ")" ::: "memory")
#define WAIT_L(n) asm volatile("s_waitcnt lgkmcnt(" #n ")" ::: "memory")
#define BAR __builtin_amdgcn_s_barrier()
#define SCHED __builtin_amdgcn_sched_barrier(0)
#pragma unroll
    for (int a = 0; a < 2; ++a)
#pragma unroll
        for (int b = 0; b < 2; ++b)
#pragma unroll
            for (int m = 0; m < 4; ++m)
#pragma unroll
                for (int n = 0; n < 2; ++n) acc[a][b][m][n] = (f32x4){0.f, 0.f, 0.f, 0.f};
    bf16x8 At[4][2], B0[2][2], B1[2][2];
    const int nt = K >> 6;
    STAGE_B(0, 0, 0); STAGE_A(0, 0, 0);
    STAGE_B(0, 1, 0); STAGE_A(0, 1, 0);
    if (wr == 1) BAR;
    WAIT_V(4); BAR;
    STAGE_B(1, 0, 1); STAGE_A(1, 0, 1); STAGE_B(1, 1, 1);
    WAIT_V(6); BAR;
    for (int tt = 0; tt < nt - 2; tt += 2) {
        LAUNDER_OFFS;
        LDB(B0, 0, 0); SCHED; LDA(At, 0, 0); STAGE_A(1, 1, tt + 1);
        WAIT_L(8); BAR; WAIT_L(0); MMA(0, 0, At, B0); BAR; SCHED;
        LDB(B1, 0, 1); STAGE_B(0, 0, tt + 2);
        BAR; WAIT_L(0); MMA(0, 1, At, B1); BAR;
        LDA(At, 0, 1); STAGE_A(0, 0, tt + 2);
        BAR; WAIT_L(0); MMA(1, 0, At, B0); BAR; SCHED;
        STAGE_B(0, 1, tt + 2);
        WAIT_V(6); BAR; MMA(1, 1, At, B1); BAR;
        LDB(B0, 1, 0); SCHED; LDA(At, 1, 0); STAGE_A(0, 1, tt + 2);
        WAIT_L(8); BAR; WAIT_L(0); MMA(0, 0, At, B0); BAR; SCHED;
        LDB(B1, 1, 1); STAGE_B(1, 0, tt + 3);
        BAR; WAIT_L(0); MMA(0, 1, At, B1); BAR;
        LDA(At, 1, 1); STAGE_A(1, 0, tt + 3);
        BAR; WAIT_L(0); MMA(1, 0, At, B0); BAR; SCHED;
        STAGE_B(1, 1, tt + 3);
        WAIT_V(6); BAR; MMA(1, 1, At, B1); BAR;
    }
    LAUNDER_OFFS;
    {   LDB(B0, 0, 0); LDA(At, 0, 0); STAGE_A(1, 1, nt - 1);
        BAR; WAIT_L(0); MMA(0, 0, At, B0); BAR;
        LDB(B1, 0, 1); BAR; WAIT_L(0); MMA(0, 1, At, B1); BAR;
        LDA(At, 0, 1); WAIT_V(4); BAR; WAIT_L(0); MMA(1, 0, At, B0); MMA(1, 1, At, B1); BAR; }
    {   LDB(B0, 1, 0); LDA(At, 1, 0); WAIT_V(2); BAR; WAIT_L(0); MMA(0, 0, At, B0); BAR;
        LDB(B1, 1, 1); WAIT_V(0); BAR; WAIT_L(0); MMA(0, 1, At, B1); BAR;
        LDA(At, 1, 1); BAR; WAIT_L(0); MMA(1, 0, At, B0); MMA(1, 1, At, B1); BAR; }
    if (wr == 0) BAR;
    __syncthreads();
}

DI void stage_rm(const f32x4 (&acc)[2][2][4][2], char* lds, int csb, int bjs, int wcoff, int lane, int wr, float sc) {
    const int fr = lane & 15, fq = lane >> 4;
#pragma unroll
    for (int ai = 0; ai < 2; ++ai)
#pragma unroll
        for (int m = 0; m < 4; ++m) {
            char* rowp = lds + (ai * 128 + wr * 64 + m * 16 + fr) * csb + (wcoff + fq * 4) * 2;
#pragma unroll
            for (int bj = 0; bj < 2; ++bj)
#pragma unroll
                for (int n = 0; n < 2; ++n) {
                    const f32x4 v = acc[ai][bj][m][n];
                    u32x2 o; o.x = pk2(v.x * sc, v.y * sc); o.y = pk2(v.z * sc, v.w * sc);
                    *(u32x2*)(rowp + (bj * bjs + n * 16) * 2) = o;
                }
        }
}
DI void stage_tr(const f32x4 (&acc)[2][2][4][2], char* lds, int bjs, int wcoff, int lane, int wr) {
    const int fr = lane & 15, fq = lane >> 4;
#pragma unroll
    for (int ai = 0; ai < 2; ++ai)
#pragma unroll
        for (int m = 0; m < 4; ++m) {
            char* colp = lds + (wcoff + fq * 4) * CS + (ai * 128 + wr * 64 + m * 16 + fr) * 2;
#pragma unroll
            for (int bj = 0; bj < 2; ++bj)
#pragma unroll
                for (int n = 0; n < 2; ++n) {
                    const f32x4 v = acc[ai][bj][m][n];
                    char* q = colp + (bj * bjs + n * 16) * CS;
                    *(unsigned short*)(q) = f2bf(v.x); *(unsigned short*)(q + CS) = f2bf(v.y);
                    *(unsigned short*)(q + 2 * CS) = f2bf(v.z); *(unsigned short*)(q + 3 * CS) = f2bf(v.w);
                }
        }
}
DI u32x4 rope_chunk(const u32x4& own, const u32x4& par, const float* __restrict__ cs, const float* __restrict__ sn, bool lo) {
    float a[8], b[8], o[8];
    unpack8(own, a); unpack8(par, b);
    const f32x4 c0 = *(const f32x4*)cs, c1 = *(const f32x4*)(cs + 4), s0 = *(const f32x4*)sn, s1 = *(const f32x4*)(sn + 4);
    const float cc[8] = {c0.x, c0.y, c0.z, c0.w, c1.x, c1.y, c1.z, c1.w};
    const float ss[8] = {s0.x, s0.y, s0.z, s0.w, s1.x, s1.y, s1.z, s1.w};
    const float sg = lo ? -1.f : 1.f;
#pragma unroll
    for (int j = 0; j < 8; ++j) o[j] = a[j] * cc[j] + sg * b[j] * ss[j];
    return pack8(o);
}
DI u32x4 rope_chunk_v(const u32x4& own, const u32x4& par, const f32x4& c0, const f32x4& c1, const f32x4& s0, const f32x4& s1, bool lo) {
    float a[8], b[8], o[8];
    unpack8(own, a); unpack8(par, b);
    const float cc[8] = {c0.x, c0.y, c0.z, c0.w, c1.x, c1.y, c1.z, c1.w};
    const float ss[8] = {s0.x, s0.y, s0.z, s0.w, s1.x, s1.y, s1.z, s1.w};
    const float sg = lo ? -1.f : 1.f;
#pragma unroll
    for (int j = 0; j < 8; ++j) o[j] = a[j] * cc[j] + sg * b[j] * ss[j];
    return pack8(o);
}
DI void store_rm(const char* lds, bf16_t* __restrict__ dst, long ld) {
    const int t = tid(), c = t & 31;
#pragma unroll
    for (int i = 0; i < 16; ++i) {
        const int rr = (t >> 5) + 16 * i;
        *(u32x4*)(dst + (long)rr * ld + c * 8) = *(const u32x4*)(lds + rr * CS + c * 16);
    }
}

DI void phase_gemm_a_in(const Params& p, char* smem) {
    const int CB = p.CB, MT = CB * 8, mt0 = 0;
    const long total = (long)MT * 40, tpad = (total + 255) & ~255L;
    for (long L = bidx(); L < tpad; L += gridDim.x) {
        const int xcd = (int)(L & 7); const long j = L >> 3;
        const int S = (int)(j >> 5) * 8 + xcd, wi = (int)(j & 31);
        const int sm = S / 10, sn = S - sm * 10;
        const int mtl = sm * 8 + (wi & 7), nt = sn * 4 + (wi >> 3);
        if (mtl >= MT) continue;
        const int mt = mt0 + mtl;
        const int col0 = nt * 256;
        const int bl = mt >> 3, pp0 = (mt & 7) << 8;
        f32x4 acc[2][2][4][2];
        const bool grp = col0 < 9216;
        const int g = grp ? col0 / 3072 : 0, rem = col0 - g * 3072, which = rem >> 10, head0 = (rem & 1023) >> 7;
        const int dsh = 2 * g, Lsh = 11 - dsh, Lm = (2048 >> dsh) - 1;
        {
            int R0, C0; stage_rc(tid() * 16, R0, C0);
            const int ppa = pp0 + R0, tka = ((ppa & Lm) << dsh) + (ppa >> Lsh);
            const int t0u = ((pp0 & Lm) << dsh) + (pp0 >> Lsh), t2u = (((pp0 + 128) & Lm) << dsh) + ((pp0 + 128) >> Lsh);
            const long off1 = (long)(64 << dsh) * DM, off2 = (long)(t2u - t0u) * DM;
            gemm_mainloop(p.hn0 + (long)(bl * 2048 + tka) * DM + C0, off1, off2, off2 + off1, p.WaT + (long)(col0 + R0) * DM + C0, DM, DM, smem, acc);
        }
        const int te = tid(), lane = te & 63, wid = __builtin_amdgcn_readfirstlane(te >> 6), wr = wid >> 2, wc = wid & 3;
        if (grp) {
            const long hb0 = (long)(g * CB + bl) * 8 + head0;
            if (which < 2) {
                if (wc == 0) {
                    const int fr = lane & 15, fq = lane >> 4;
#pragma unroll
                    for (int ai = 0; ai < 2; ++ai) {
                        f32x4 cv[4], sv[4];
#pragma unroll
                        for (int m = 0; m < 4; ++m) {
                            const int pp = pp0 + ai * 128 + wr * 64 + m * 16 + fr;
                            const long tokc = (long)bl * 2048 + ((pp & Lm) << dsh) + (pp >> Lsh);
                            cv[m] = *(const f32x4*)(p.cosA + tokc * 16 + fq * 4); sv[m] = *(const f32x4*)(p.sinA + tokc * 16 + fq * 4);
                        }
#pragma unroll
                        for (int m = 0; m < 4; ++m)
#pragma unroll
                            for (int bj = 0; bj < 2; ++bj) {
                                const f32x4 x1 = acc[ai][bj][m][0], x2 = acc[ai][bj][m][1];
                                acc[ai][bj][m][0] = x1 * cv[m] - x2 * sv[m];
                                acc[ai][bj][m][1] = x2 * cv[m] + x1 * sv[m];
                            }
                    }
                }
                stage_rm(acc, smem, CS, 128, wc * 32, lane, wr, which == 0 ? QSCALE_A : 1.0f);
                __syncthreads();
                const int t2 = tid();
                const int c = t2 & 31, cc = c & 15;
                bf16_t* dst = (which == 0 ? p.Qa : p.Ka) + (hb0 + (c >> 4)) * 2048 * 128 + cc * 8;
#pragma unroll
                for (int i = 0; i < 16; ++i) {
                    const int rr = (t2 >> 5) + 16 * i, pp = pp0 + rr;
                    __builtin_nontemporal_store(*(const u32x4*)(smem + rr * CS + c * 16), (u32x4*)(dst + (long)pp * 128));
                }
            } else {
                stage_tr(acc, smem, 128, wc * 32, lane, wr);
                __syncthreads();
                const int t2 = tid();
                const int c = t2 & 31;
                bf16_t* dst = p.VaT + (hb0 * 128 + (t2 >> 5)) * 2048 + pp0 + c * 8;
                const char* src = smem + (t2 >> 5) * CS + c * 16;
#pragma unroll
                for (int i = 0; i < 16; ++i) __builtin_nontemporal_store(*(const u32x4*)(src + i * 16 * CS), (u32x4*)(dst + (long)i * 16 * 2048));
            }
        } else {
            stage_rm(acc, smem, CS, 128, wc * 32, lane, wr, 1.0f);
            __syncthreads();
            store_rm(smem, p.Za + (long)mt * 256 * DM + (col0 - 9216), DM);
        }
        __syncthreads();
    }
}

DI bool narrow_map(long L, int NTn, int MT, int& mt, int& nt) {
    const int xcd = (int)(L & 7); const long j = L >> 3;
    mt = (int)(j / NTn) * 8 + xcd; nt = (int)(j % NTn);
    return mt < MT;
}

DI void phase_gemm_plain(const Params& p, char* smem, const bf16_t* A, const bf16_t* Wt, bf16_t* O) {
    const int MT = p.CB * 8;
    const long total = (long)MT * 4;
    const int t = tid(), lane = t & 63, wid = t >> 6, wr = wid >> 2, wc = wid & 3;
    int R0, C0; stage_rc(t * 16, R0, C0);
    for (long L = bidx(); L < total; L += gridDim.x) {
        int mt, nt; if (!narrow_map(L, 4, MT, mt, nt)) continue;
        f32x4 acc[2][2][4][2];
        gemm_mainloop(A + (long)(mt * 256 + R0) * DM + C0, 64 * DM, 128 * DM, 192 * DM, Wt + (long)(nt * 256 + R0) * DM + C0, DM, DM, smem, acc);
        stage_rm(acc, smem, CS, 128, wc * 32, lane, wr, 1.0f);
        __syncthreads();
        store_rm(smem, O + (long)mt * 256 * DM + nt * 256, DM);
        __syncthreads();
    }
}

DI void phase_gemm_down(const Params& p, char* smem) {
    const int MT = p.CB * 8;
    const long total = (long)MT * 7;
    const int t = tid(), lane = t & 63, wid = t >> 6, wr = wid >> 2, wc = wid & 3;
    int R0, C0; stage_rc(t * 16, R0, C0);
    for (long L = bidx(); L < total; L += gridDim.x) {
        int mt, nt; if (!narrow_map(L, 7, MT, mt, nt)) continue;
        f32x4 acc[2][2][4][2];
        gemm_mainloop(p.hn1 + (long)(mt * 256 + R0) * DM + C0, 64 * DM, 128 * DM, 192 * DM, p.WdT + (long)(nt * 256 + R0) * DM + C0, DM, DM, smem, acc);
        stage_rm(acc, smem, CS, 128, wc * 32, lane, wr, 1.0f);
        __syncthreads();
        const int t2 = tid();
        const int c = t2 & 31, col = nt * 256 + c * 8;
        if (nt == 0) {
            const f32x4 g0 = *(const f32x4*)(p.kv_lat + col), g1 = *(const f32x4*)(p.kv_lat + col + 4);
#pragma unroll 4
            for (int i = 0; i < 16; ++i) {
                const int rr = (t2 >> 5) + 16 * i;
                float f[8]; unpack8(*(const u32x4*)(smem + rr * CS + c * 16), f);
                float ss = 0.f;
#pragma unroll
                for (int j = 0; j < 8; ++j) ss += f[j] * f[j];
                ss += __shfl_xor(ss, 1); ss += __shfl_xor(ss, 2); ss += __shfl_xor(ss, 4); ss += __shfl_xor(ss, 8); ss += __shfl_xor(ss, 16);
                const float rstd = rsqrtf(ss * (1.0f / 256.0f) + EPS);
                float o[8] = {f[0] * rstd * g0.x, f[1] * rstd * g0.y, f[2] * rstd * g0.z, f[3] * rstd * g0.w, f[4] * rstd * g1.x, f[5] * rstd * g1.y, f[6] * rstd * g1.z, f[7] * rstd * g1.w};
                *(u32x4*)(p.ckvn + (long)(mt * 256 + rr) * 256 + col) = pack8(o);
            }
        } else if (nt <= 2) {
            const bool isr = col < 288, isq = !isr && col < 672;
#pragma unroll
            for (int hf = 0; hf < 4; ++hf) {
                f32x4 tc0[4], tc1[4], ts0[4], ts1[4];
#pragma unroll
                for (int k = 0; k < 4; ++k) {
                    const long tok = (long)mt * 256 + (t2 >> 5) + 16 * (hf * 4 + k);
                    const float* cs = p.cosB + tok * 16 + (c & 1) * 8; const float* sn = p.sinB + tok * 16 + (c & 1) * 8;
                    tc0[k] = *(const f32x4*)cs; tc1[k] = *(const f32x4*)(cs + 4); ts0[k] = *(const f32x4*)sn; ts1[k] = *(const f32x4*)(sn + 4);
                }
#pragma unroll
                for (int k = 0; k < 4; ++k) {
                    const int rr = (t2 >> 5) + 16 * (hf * 4 + k);
                    const long tok = (long)mt * 256 + rr;
                    u32x4 v = *(const u32x4*)(smem + rr * CS + c * 16);
                    float ss = 0.f;
                    if (isr) {
                        const u32x4 pv = *(const u32x4*)(smem + rr * CS + (c ^ 2) * 16);
                        v = rope_chunk_v(v, pv, tc0[k], tc1[k], ts0[k], ts1[k], c < 2);
                        *(u32x4*)(p.krope + tok * 32 + c * 8) = v;
                    } else if (isq) {
                        *(u32x4*)(p.cq + tok * 384 + (col - 288)) = v;
                        float f[8]; unpack8(v, f);
#pragma unroll
                        for (int j = 0; j < 8; ++j) ss += f[j] * f[j];
                    } else {
                        *(u32x4*)(p.zb + tok * DM + (col - 672)) = v;
                    }
                    ss += __shfl_xor(ss, 1); ss += __shfl_xor(ss, 2); ss += __shfl_xor(ss, 4); ss += __shfl_xor(ss, 8); ss += __shfl_xor(ss, 16);
                    if (c == 0) atomicAdd(p.ssq + tok, ss);
                }
            }
        } else if (col < 1696) {
            bf16_t* dst = p.zb + (col - 672);
#pragma unroll
            for (int i = 0; i < 16; ++i) {
                const int rr = (t2 >> 5) + 16 * i;
                *(u32x4*)(dst + (long)(mt * 256 + rr) * DM) = *(const u32x4*)(smem + rr * CS + c * 16);
            }
        }
        __syncthreads();
    }
}

DI void phase_gemm_up(const Params& p, char* smem) {
    const int MT = p.CB * 8;
    const long total = (long)MT * 14;
    const int t = tid(), lane = t & 63, wid = t >> 6, wr = wid >> 2, wc = wid & 3;
    int R0, C0; stage_rc(t * 16, R0, C0);
    for (long L = bidx(); L < total; L += gridDim.x) {
        int mt, nt; if (!narrow_map(L, 14, MT, mt, nt)) continue;
        const int bl = mt >> 3, tt0 = (mt & 7) << 8;
        f32x4 acc[2][2][4][2];
        {
            const bool kv = nt < 8;
            const int Kd = kv ? 256 : 384;
            const bf16_t* a0 = (kv ? p.ckvn : p.cq) + (long)(mt * 256 + R0) * Kd + C0;
            const bf16_t* b0 = (kv ? p.WkvuT + (long)(nt * 256 + R0) * 256 : p.WquT + (long)((nt - 8) * 256 + R0) * 384) + C0;
            gemm_mainloop(a0, 64 * Kd, 128 * Kd, 192 * Kd, b0, Kd, Kd, smem, acc);
        }
        if (nt < 8) {
            if (wc < 2) stage_rm(acc, smem, CSH, 64, wc * 32, lane, wr, 1.0f);
            else stage_tr(acc, smem + 256 * CSH, 64, (wc - 2) * 32, lane, wr);
            __syncthreads();
            const int t2 = tid();
            {
                const int c = t2 & 15, head = 2 * nt + (c >> 3), cc = c & 7;
                bf16_t* dst = p.Kb + ((long)(bl * 16 + head) * 2048 + tt0) * 64 + cc * 8;
#pragma unroll
                for (int i = 0; i < 8; ++i) { const int rr = (t2 >> 4) + 32 * i; *(u32x4*)(dst + (long)rr * 64) = *(const u32x4*)(smem + rr * CSH + c * 16); }
            }
            {
                const int c = t2 & 31;
#pragma unroll
                for (int i = 0; i < 8; ++i) {
                    const int n = (t2 >> 5) + 16 * i, head = 2 * nt + (n >> 6), d = n & 63;
                    *(u32x4*)(p.VbT + ((long)(bl * 16 + head) * 64 + d) * 2048 + tt0 + c * 8) = *(const u32x4*)(smem + 256 * CSH + n * CS + c * 16);
                }
            }
        } else {
            const int n2 = nt - 8;
            stage_rm(acc, smem, CS, 128, wc * 32, lane, wr, 1.0f);
            __syncthreads();
            const int t2 = tid();
            const int c = t2 & 31;
            const int col = n2 * 256 + c * 8, head = col / 96, d = col - head * 96;
            bf16_t* dst = p.Qb + ((long)(bl * 16 + head) * 2048 + tt0) * 96 + d;
            float rsv[16];
#pragma unroll
            for (int i = 0; i < 16; ++i) rsv[i] = p.ssq[(long)mt * 256 + (t2 >> 5) + 16 * i];
#pragma unroll
            for (int i = 0; i < 16; ++i) rsv[i] = rsqrtf(rsv[i] * (1.0f / 384.0f) + EPS) * QSCALE_B;
            const bool isrot = d >= 64, lo = d < 80;
            const int pc = isrot ? (lo ? c + 2 : c - 2) : c;
#pragma unroll
            for (int hf = 0; hf < 4; ++hf) {
                f32x4 tc0[4], tc1[4], ts0[4], ts1[4];
#pragma unroll
                for (int k = 0; k < 4; ++k) {
                    const long tokc = (long)mt * 256 + (t2 >> 5) + 16 * (hf * 4 + k);
                    const float* cs = p.cosB + tokc * 16 + (d & 8); const float* sn = p.sinB + tokc * 16 + (d & 8);
                    tc0[k] = *(const f32x4*)cs; tc1[k] = *(const f32x4*)(cs + 4); ts0[k] = *(const f32x4*)sn; ts1[k] = *(const f32x4*)(sn + 4);
                }
#pragma unroll
                for (int k = 0; k < 4; ++k) {
                    const int i = hf * 4 + k;
                    const int rr = (t2 >> 5) + 16 * i;
                    u32x4 v = *(const u32x4*)(smem + rr * CS + c * 16);
                    const u32x4 pv = *(const u32x4*)(smem + rr * CS + pc * 16);
                    const u32x4 vr = rope_chunk_v(v, pv, tc0[k], tc1[k], ts0[k], ts1[k], lo);
                    v = isrot ? vr : v;
                    {
                        const float rs = rsv[i];
                        float f[8]; unpack8(v, f);
#pragma unroll
                        for (int j = 0; j < 8; ++j) f[j] *= rs;
                        v = pack8(f);
                    }
                    *(u32x4*)(dst + (long)rr * 96) = v;
                }
            }
        }
        __syncthreads();
    }
}

template <int DQK, int DV, bool ISA>
DI void attn_unit(const Params& p, char* smem, const bf16_t* __restrict__ Q, const bf16_t* __restrict__ K, const bf16_t* __restrict__ Kr, const bf16_t* __restrict__ Vt,
                  int q0, int kstart, int ntiles, int W, int segm, int e0, int e1, int e2, int e3) {
    constexpr int KS = DQK * 2 + 16, VS = 144;
    constexpr int KB = 64 * KS, VB = DV * VS, STAGE = KB + VB;
    constexpr int NS = DQK / 16, NDB = DV / 32;
    constexpr int KCH = DQK / 8, NKC = 64 * KCH, NKL = (NKC + NTHR - 1) / NTHR, NVL = DV * 8 / NTHR;
    static_assert(2 * STAGE <= SMEM_BYTES, "attention LDS");
    const int t = tid(), lane = t & 63, w = t >> 6, q = lane & 31, h = lane >> 5;
    bf16x8 qf[NS];
    {
        const bf16_t* qp = Q + (long)(w * 32 + q) * DQK + 8 * h;
#pragma unroll
        for (int s = 0; s < NS; ++s) qf[s] = *(const bf16x8*)(qp + 16 * s);
    }
    u32x4 rk[NKL], rv[NVL];
    auto gload = [&](int k0) {
#pragma unroll
        for (int i = 0; i < NKL; ++i) {
            const int idx = t + NTHR * i, kr = idx / KCH, c = idx - kr * KCH;
            if ((NKC % NTHR) == 0 || idx < NKC) rk[i] = ISA ? *(const u32x4*)(K + (long)(k0 + kr) * DQK + c * 8)
                                                          : (c < 8 ? *(const u32x4*)(K + (long)(k0 + kr) * 64 + c * 8) : *(const u32x4*)(Kr + (long)(k0 + kr) * 32 + (c - 8) * 8));
        }
#pragma unroll
        for (int i = 0; i < NVL; ++i) { const int idx = t + NTHR * i, d = idx >> 3, c = idx & 7; rv[i] = *(const u32x4*)(Vt + (long)d * 2048 + k0 + c * 8); }
    };
    auto lwrite = [&](char* st) {
#pragma unroll
        for (int i = 0; i < NKL; ++i) {
            const int idx = t + NTHR * i, kr = idx / KCH, c = idx - kr * KCH;
            if ((NKC % NTHR) == 0 || idx < NKC) *(u32x4*)(st + kr * KS + c * 16) = rk[i];
        }
#pragma unroll
        for (int i = 0; i < NVL; ++i) {
            const int idx = t + NTHR * i, d = idx >> 3, c = idx & 7;
            char* vp = st + KB + d * VS + ((c >> 1) * 16 + 4 * (c & 1)) * 2;
            u32x2 a = {rv[i].x, rv[i].y}, b = {rv[i].z, rv[i].w};
            *(u32x2*)vp = a; *(u32x2*)(vp + 16) = b;
        }
    };
    float m = -1e30f, l = 0.f;
    f32x16 o[NDB];
#pragma unroll
    for (int db = 0; db < NDB; ++db)
#pragma unroll
        for (int i = 0; i < 16; ++i) o[db][i] = 0.f;
    gload(kstart); lwrite(smem); __syncthreads();
    const int qw0 = q0 + w * 32;
    const int seg0 = qw0 & ~segm;
    const int klo = max(qw0 - W, seg0);
    for (int kt = 0; kt < ntiles; ++kt) {
        const char* st = smem + (kt & 1) * STAGE;
        const int k0 = kstart + kt * 64;
        if (kt + 1 < ntiles) gload(k0 + 64);
        __builtin_amdgcn_sched_barrier(0);
        const bool need = (k0 <= qw0 + 31) && (k0 + 63 >= klo);
        if (need) {
            f32x16 s0, s1;
#pragma unroll
            for (int i = 0; i < 16; ++i) { s0[i] = 0.f; s1[i] = 0.f; }
            const char* kp = st + q * KS + h * 16;
            {
                bf16x8 kfa[NS], kfb[NS];
#pragma unroll
                for (int s = 0; s < NS; ++s) kfa[s] = *(const bf16x8*)(kp + s * 32);
#pragma unroll
                for (int s = 0; s < NS; ++s) kfb[s] = *(const bf16x8*)(kp + 32 * KS + s * 32);
                __builtin_amdgcn_sched_barrier(0);
#pragma unroll
                for (int s = 0; s < NS; ++s) s0 = MFMA(kfa[s], qf[s], s0);
#pragma unroll
                for (int s = 0; s < NS; ++s) s1 = MFMA(kfb[s], qf[s], s1);
            }
            const bool full = (k0 + 63 <= qw0) && (k0 >= max(qw0 + 31 - W, seg0));
            if (!full) {
                const int qpos = qw0 + q;
                const int lo = max(qpos - W, seg0);
#pragma unroll
                for (int i = 0; i < 16; ++i) {
                    const int key = k0 + (i & 3) + 8 * (i >> 2) + 4 * h;
                    const bool ok0 = (key <= qpos) && (key >= lo);
                    const bool ok1 = (key + 32 <= qpos) && (key + 32 >= lo);
                    s0[i] = ok0 ? s0[i] : -INFINITY; s1[i] = ok1 ? s1[i] : -INFINITY;
                }
            }
            float mx = fmaxf(s0[0], s1[0]);
#pragma unroll
            for (int i = 1; i < 16; ++i) mx = fmaxf(mx, fmaxf(s0[i], s1[i]));
            mx = fmaxf(mx, __shfl_xor(mx, 32));
            const float mn = fmaxf(m, mx), alpha = fexp2(m - mn);
            m = mn;
            float ps = 0.f;
#pragma unroll
            for (int i = 0; i < 16; ++i) { s0[i] = fexp2(s0[i] - mn); s1[i] = fexp2(s1[i] - mn); ps += s0[i] + s1[i]; }
            l = l * alpha + ps;
#pragma unroll
            for (int db = 0; db < NDB; ++db)
#pragma unroll
                for (int i = 0; i < 16; ++i) o[db][i] *= alpha;
            const char* vp = st + KB + q * VS + h * 16;
            u32x4 pp[4];
            pp[0].x = pk2(s0[0], s0[1]);  pp[0].y = pk2(s0[2], s0[3]);   pp[0].z = pk2(s0[4], s0[5]);   pp[0].w = pk2(s0[6], s0[7]);
            pp[1].x = pk2(s0[8], s0[9]);  pp[1].y = pk2(s0[10], s0[11]); pp[1].z = pk2(s0[12], s0[13]); pp[1].w = pk2(s0[14], s0[15]);
            pp[2].x = pk2(s1[0], s1[1]);  pp[2].y = pk2(s1[2], s1[3]);   pp[2].z = pk2(s1[4], s1[5]);   pp[2].w = pk2(s1[6], s1[7]);
            pp[3].x = pk2(s1[8], s1[9]);  pp[3].y = pk2(s1[10], s1[11]); pp[3].z = pk2(s1[12], s1[13]); pp[3].w = pk2(s1[14], s1[15]);
#pragma unroll
            for (int gp = 0; gp < 2; ++gp) {
                bf16x8 vf[2][NDB];
#pragma unroll
                for (int gg = 0; gg < 2; ++gg)
#pragma unroll
                    for (int db = 0; db < NDB; ++db) vf[gg][db] = *(const bf16x8*)(vp + db * 32 * VS + (gp * 2 + gg) * 32);
                __builtin_amdgcn_sched_barrier(0);
#pragma unroll
                for (int gg = 0; gg < 2; ++gg)
#pragma unroll
                    for (int db = 0; db < NDB; ++db) o[db] = MFMA(vf[gg][db], __builtin_bit_cast(bf16x8, pp[gp * 2 + gg]), o[db]);
            }
        }
        if (kt + 1 < ntiles) lwrite(smem + ((kt + 1) & 1) * STAGE);
        __syncthreads();
    }
    const float lt = l + __shfl_xor(l, 32);
    const float inv = 1.0f / lt;
    const int qi = w * 32 + q;
    if (ISA) {
        const int NT = p.CB * 2048;
        const int pp = q0 + qi, dsh = e3, Lsh = 11 - dsh, Lm = (2048 >> dsh) - 1;
        const int tt = ((pp & Lm) << dsh) + (pp >> Lsh);
        const long tok = (long)e1 * 2048 + tt;
        bf16_t* dst = p.Oa + ((long)e0 * NT + tok) * DM + e2 * 128 + 4 * h;
#pragma unroll
        for (int db = 0; db < NDB; ++db)
#pragma unroll
            for (int g = 0; g < 4; ++g) {
                u32x2 v; v.x = pk2(o[db][4 * g] * inv, o[db][4 * g + 1] * inv); v.y = pk2(o[db][4 * g + 2] * inv, o[db][4 * g + 3] * inv);
                *(u32x2*)(dst + db * 32 + g * 8) = v;
            }
        if (h == 0) p.La[((long)e0 * NT + tok) * 8 + e2] = m + __log2f(lt);
    } else {
        constexpr int OS = DV * 2 + 16;
        char* orow = smem + qi * OS + 8 * h;
#pragma unroll
        for (int db = 0; db < NDB; ++db)
#pragma unroll
            for (int g = 0; g < 4; ++g) {
                u32x2 v; v.x = pk2(o[db][4 * g] * inv, o[db][4 * g + 1] * inv); v.y = pk2(o[db][4 * g + 2] * inv, o[db][4 * g + 3] * inv);
                *(u32x2*)(orow + (db * 32 + g * 8) * 2) = v;
            }
        __syncthreads();
        constexpr int CPR = DV / 8;
        const int t2 = tid(), c = t2 % CPR;
        const long tok0 = (long)e1 * 2048 + q0;
#pragma unroll
        for (int i = 0; i < (256 * CPR) / NTHR; ++i) {
            const int rr = t2 / CPR + (NTHR / CPR) * i;
            float ov[8], zv[8], y[8];
            unpack8(*(const u32x4*)(smem + rr * OS + c * 16), ov);
            unpack8(*(const u32x4*)(p.zb + (tok0 + rr) * DM + e2 * DV + c * 8), zv);
#pragma unroll
            for (int j = 0; j < 8; ++j) y[j] = ov[j] * silu(zv[j]);
            *(u32x4*)(p.y2 + (tok0 + rr) * DM + e2 * DV + c * 8) = pack8(y);
        }
        __syncthreads();
    }
}

DI void attn_unit_a(const Params& p, char* smem, const bf16_t* __restrict__ Q, const bf16_t* __restrict__ K, const bf16_t* __restrict__ Vt,
                    int q0, int kstart, int ntiles, int segm, int e0, int e1, int e2, int e3) {
    constexpr int DQK = 128, DV = 128, W = 128;
    constexpr bool ISA = true;
    constexpr int KS = DQK * 2 + 16, VS = 144;
    constexpr int KB = 64 * KS, VB = DV * VS, STAGE = KB + VB;
    constexpr int NS = DQK / 16, NDB = DV / 32;
    constexpr int KCH = DQK / 8;
    static_assert(4 * STAGE <= SMEM_BYTES, "attention-A LDS");
    const int t = tid(), lane = t & 63, w = t >> 6, q = lane & 31, h = lane >> 5;
    bf16x8 qf[NS];
    {
        const bf16_t* qp = Q + (long)(w * 32 + q) * DQK + 8 * h;
#pragma unroll
        for (int s = 0; s < NS; ++s) qf[s] = *(const bf16x8*)(qp + 16 * s);
    }
    const int kr0 = t >> 4, kc = t & 15, vd0 = t >> 3, vc = t & 7;
    const bf16_t* kg = K + (long)(kstart + kr0) * DQK + kc * 8;
    const bf16_t* vg = Vt + (long)vd0 * 2048 + kstart + vc * 8;
    const int kwo = kr0 * KS + kc * 16, vwo = KB + vd0 * VS + ((vc >> 1) * 16 + 4 * (vc & 1)) * 2;
    auto gload = [&](int tile, u32x4 (&r)[4]) {
        r[0] = *(const u32x4*)(kg + (long)(tile * 64) * DQK); r[1] = *(const u32x4*)(kg + (long)(tile * 64 + 32) * DQK);
        r[2] = *(const u32x4*)(vg + tile * 64);               r[3] = *(const u32x4*)(vg + 64 * 2048 + tile * 64);
    };
    auto lwrite = [&](char* st, const u32x4 (&r)[4]) {
        *(u32x4*)(st + kwo) = r[0]; *(u32x4*)(st + kwo + 32 * KS) = r[1];
        { u32x2 a = {r[2].x, r[2].y}, b = {r[2].z, r[2].w}; *(u32x2*)(st + vwo) = a; *(u32x2*)(st + vwo + 16) = b; }
        { u32x2 a = {r[3].x, r[3].y}, b = {r[3].z, r[3].w}; *(u32x2*)(st + vwo + 64 * VS) = a; *(u32x2*)(st + vwo + 64 * VS + 16) = b; }
    };
    {
        u32x4 r0[4], r1[4], r2[4], r3[4];
        gload(0, r0); gload(1, r1); gload(2, r2); gload(3, r3);
        lwrite(smem, r0); lwrite(smem + STAGE, r1); lwrite(smem + 2 * STAGE, r2); lwrite(smem + 3 * STAGE, r3);
    }
    float m = -1e30f, l = 0.f;
    f32x16 o[NDB];
#pragma unroll
    for (int db = 0; db < NDB; ++db)
#pragma unroll
        for (int i = 0; i < 16; ++i) o[db][i] = 0.f;
    __syncthreads();
    const int qw0 = q0 + w * 32;
    const int seg0 = qw0 & ~segm;
    const int klo = max(qw0 - W, seg0);
    const int off = (q0 - kstart) >> 6;
    u32x4 rn[4];
    for (int it = 0; it < 3; ++it) {
        if (it + 4 < ntiles) gload(it + 4, rn);
        __builtin_amdgcn_sched_barrier(0);
        const int tile = (w >> 1) + off - 2 + it;
        const int k0 = kstart + tile * 64;
        const char* st = smem + (tile & 3) * STAGE;
        const bool need = (tile >= 0) && (tile < ntiles) && (k0 <= qw0 + 31) && (k0 + 63 >= klo);
        if (need) {
            f32x16 s0, s1;
#pragma unroll
            for (int i = 0; i < 16; ++i) { s0[i] = 0.f; s1[i] = 0.f; }
            const char* kp = st + q * KS + h * 16;
            {
                bf16x8 kfa[NS], kfb[NS];
#pragma unroll
                for (int s = 0; s < NS; ++s) kfa[s] = *(const bf16x8*)(kp + s * 32);
#pragma unroll
                for (int s = 0; s < NS; ++s) kfb[s] = *(const bf16x8*)(kp + 32 * KS + s * 32);
                __builtin_amdgcn_sched_barrier(0);
#pragma unroll
                for (int s = 0; s < NS; ++s) s0 = MFMA(kfa[s], qf[s], s0);
#pragma unroll
                for (int s = 0; s < NS; ++s) s1 = MFMA(kfb[s], qf[s], s1);
            }
            const bool full = (k0 + 63 <= qw0) && (k0 >= max(qw0 + 31 - W, seg0));
            if (!full) {
                const int qpos = qw0 + q;
                const int lo = max(qpos - W, seg0);
#pragma unroll
                for (int i = 0; i < 16; ++i) {
                    const int key = k0 + (i & 3) + 8 * (i >> 2) + 4 * h;
                    const bool ok0 = (key <= qpos) && (key >= lo);
                    const bool ok1 = (key + 32 <= qpos) && (key + 32 >= lo);
                    s0[i] = ok0 ? s0[i] : -INFINITY; s1[i] = ok1 ? s1[i] : -INFINITY;
                }
            }
            float mx = fmaxf(s0[0], s1[0]);
#pragma unroll
            for (int i = 1; i < 16; ++i) mx = fmaxf(mx, fmaxf(s0[i], s1[i]));
            mx = fmaxf(mx, __shfl_xor(mx, 32));
            const float mn = fmaxf(m, mx), alpha = fexp2(m - mn);
            m = mn;
            float ps = 0.f;
#pragma unroll
            for (int i = 0; i < 16; ++i) { s0[i] = fexp2(s0[i] - mn); s1[i] = fexp2(s1[i] - mn); ps += s0[i] + s1[i]; }
            l = l * alpha + ps;
#pragma unroll
            for (int db = 0; db < NDB; ++db)
#pragma unroll
                for (int i = 0; i < 16; ++i) o[db][i] *= alpha;
            const char* vp = st + KB + q * VS + h * 16;
            u32x4 pp[4];
            pp[0].x = pk2(s0[0], s0[1]);  pp[0].y = pk2(s0[2], s0[3]);   pp[0].z = pk2(s0[4], s0[5]);   pp[0].w = pk2(s0[6], s0[7]);
            pp[1].x = pk2(s0[8], s0[9]);  pp[1].y = pk2(s0[10], s0[11]); pp[1].z = pk2(s0[12], s0[13]); pp[1].w = pk2(s0[14], s0[15]);
            pp[2].x = pk2(s1[0], s1[1]);  pp[2].y = pk2(s1[2], s1[3]);   pp[2].z = pk2(s1[4], s1[5]);   pp[2].w = pk2(s1[6], s1[7]);
            pp[3].x = pk2(s1[8], s1[9]);  pp[3].y = pk2(s1[10], s1[11]); pp[3].z = pk2(s1[12], s1[13]); pp[3].w = pk2(s1[14], s1[15]);
#pragma unroll
            for (int gp = 0; gp < 2; ++gp) {
                bf16x8 vf[2][NDB];
#pragma unroll
                for (int gg = 0; gg < 2; ++gg)
#pragma unroll
                    for (int db = 0; db < NDB; ++db) vf[gg][db] = *(const bf16x8*)(vp + db * 32 * VS + (gp * 2 + gg) * 32);
                __builtin_amdgcn_sched_barrier(0);
#pragma unroll
                for (int gg = 0; gg < 2; ++gg)
#pragma unroll
                    for (int db = 0; db < NDB; ++db) o[db] = MFMA(vf[gg][db], __builtin_bit_cast(bf16x8, pp[gp * 2 + gg]), o[db]);
            }
        }
        if (it + 4 < ntiles) {
            __syncthreads();
            lwrite(smem + (it & 3) * STAGE, rn);
        }
        __syncthreads();
    }
    const float lt = l + __shfl_xor(l, 32);
    const float inv = 1.0f / lt;
    const int qi = w * 32 + q;
    {
        const int NT = p.CB * 2048;
        const int dsh = e3, Lsh = 11 - dsh, Lm = (2048 >> dsh) - 1;
        char* orow = smem + qi * 272 + 8 * h;
#pragma unroll
        for (int db = 0; db < NDB; ++db)
#pragma unroll
            for (int g = 0; g < 4; ++g) {
                u32x2 v; v.x = pk2(o[db][4 * g] * inv, o[db][4 * g + 1] * inv); v.y = pk2(o[db][4 * g + 2] * inv, o[db][4 * g + 3] * inv);
                *(u32x2*)(orow + (db * 32 + g * 8) * 2) = v;
            }
        if (h == 0) {
            const int pp = q0 + qi, tt = ((pp & Lm) << dsh) + (pp >> Lsh);
            p.La[((long)e0 * NT + (long)e1 * 2048 + tt) * 8 + e2] = m + __log2f(lt);
        }
        __syncthreads();
        const int t2 = tid(), c = t2 & 15;
        bf16_t* dst = p.Oa + ((long)e0 * NT + (long)e1 * 2048) * DM + e2 * 128 + c * 8;
#pragma unroll
        for (int i = 0; i < 8; ++i) {
            const int rr = (t2 >> 4) + 32 * i, pp = q0 + rr, tt = ((pp & Lm) << dsh) + (pp >> Lsh);
            *(u32x4*)(dst + (long)tt * DM) = *(const u32x4*)(smem + rr * 272 + c * 16);
        }
        __syncthreads();
    }
}

DI void phase_attn_a(const Params& p, char* smem) {
    const int NBL = p.CB, bl0 = 0;
    const int CB = p.CB;
    const long total = (long)3 * NBL * 8 * 8;
    for (long L = bidx(); L < total; L += gridDim.x) {
        const long it = L >> 8; const int v0 = (int)(L & 255);
        const int v = (v0 & 7) * 32 + (v0 >> 3);
        const long u = it * 256 + v;
        if (u >= total) continue;
        const int blk = (int)(u & 7); const long hbs = u >> 3;
        const int head = (int)(hbs & 7); const int gb = (int)(hbs >> 3); const int g = gb / NBL, bl = bl0 + (gb - g * NBL);
        const long hb = (long)(g * CB + bl) * 8 + head;
        const int dsh = 2 * g, Lm = (2048 >> dsh) - 1;
        const int pp0 = blk * 256;
        const int segs = pp0 & ~Lm;
        const int kstart = max(pp0 - 128, segs);
        const int nt = (pp0 + 256 - kstart) >> 6;
        attn_unit_a(p, smem, p.Qa + (hb * 2048 + pp0) * 128, p.Ka + hb * 2048 * 128, p.VaT + hb * 128 * 2048,
                    pp0, kstart, nt, Lm, g, bl, head, dsh);
    }
}

DI void attn_unit_b(const Params& p, char* smem, const bf16_t* __restrict__ Q, const bf16_t* __restrict__ K, const bf16_t* __restrict__ Kr, const bf16_t* __restrict__ Vt,
                    int q0, int ntiles  , int e1, int e2) {
    constexpr int DQK = 96, DV = 64, TK = 128;
    constexpr int KS = DQK * 2 + 16, VS = TK * 2 + 16;
    constexpr int KB = TK * KS, VB = DV * VS, STAGE = KB + VB;
    constexpr int NS = DQK / 16, NDB = DV / 32;
    static_assert(2 * STAGE <= SMEM_BYTES, "attention-B LDS");
    const int t = tid(), lane = t & 63, w = t >> 6, q = lane & 31, h = lane >> 5;
    bf16x8 qf[NS];
    {
        const bf16_t* qp = Q + (long)(w * 32 + q) * DQK + 8 * h;
#pragma unroll
        for (int s = 0; s < NS; ++s) qf[s] = *(const bf16x8*)(qp + 16 * s);
    }
    u32x4 rk[3], rv[2];
    auto gload = [&](int k0) {
#pragma unroll
        for (int i = 0; i < 3; ++i) {
            const int idx = t + NTHR * i, kr = idx / 12, c = idx - kr * 12;
            rk[i] = c < 8 ? *(const u32x4*)(K + (long)(k0 + kr) * 64 + c * 8) : *(const u32x4*)(Kr + (long)(k0 + kr) * 32 + (c - 8) * 8);
        }
#pragma unroll
        for (int i = 0; i < 2; ++i) { const int idx = t + NTHR * i, d = idx >> 4, c = idx & 15; rv[i] = *(const u32x4*)(Vt + (long)d * 2048 + k0 + c * 8); }
    };
    auto lwrite = [&](char* st) {
#pragma unroll
        for (int i = 0; i < 3; ++i) { const int idx = t + NTHR * i, kr = idx / 12, c = idx - kr * 12; *(u32x4*)(st + kr * KS + c * 16) = rk[i]; }
#pragma unroll
        for (int i = 0; i < 2; ++i) {
            const int idx = t + NTHR * i, d = idx >> 4, c = idx & 15;
            char* vp = st + KB + d * VS + ((c >> 1) * 16 + 4 * (c & 1)) * 2;
            u32x2 a = {rv[i].x, rv[i].y}, b = {rv[i].z, rv[i].w};
            *(u32x2*)vp = a; *(u32x2*)(vp + 16) = b;
        }
    };
    float m = -1e30f, l = 0.f;
    f32x16 o[NDB];
#pragma unroll
    for (int db = 0; db < NDB; ++db)
#pragma unroll
        for (int i = 0; i < 16; ++i) o[db][i] = 0.f;
    gload(0); lwrite(smem); __syncthreads();
    const int qw0 = q0 + w * 32;
    for (int kt = 0; kt < ntiles; ++kt) {
        const char* st = smem + (kt & 1) * STAGE;
        const int k0 = kt * TK;
        if (kt + 1 < ntiles) gload(k0 + TK);
        __builtin_amdgcn_sched_barrier(0);
        if (k0 <= qw0 + 31) {
            f32x16 sc[4];
#pragma unroll
            for (int kb = 0; kb < 4; ++kb)
#pragma unroll
                for (int i = 0; i < 16; ++i) sc[kb][i] = 0.f;
            const char* kp = st + q * KS + h * 16;
#pragma unroll
            for (int kb = 0; kb < 4; ++kb) {
                if (k0 + kb * 32 <= qw0 + 31) {
                    bf16x8 kf[NS];
#pragma unroll
                    for (int s = 0; s < NS; ++s) kf[s] = *(const bf16x8*)(kp + kb * 32 * KS + s * 32);
#pragma unroll
                    for (int s = 0; s < NS; ++s) sc[kb] = MFMA(kf[s], qf[s], sc[kb]);
                }
            }
            if (k0 + TK - 1 > qw0) {
                const int qpos = qw0 + q;
#pragma unroll
                for (int kb = 0; kb < 4; ++kb)
#pragma unroll
                    for (int i = 0; i < 16; ++i) {
                        const int key = k0 + kb * 32 + (i & 3) + 8 * (i >> 2) + 4 * h;
                        sc[kb][i] = (key <= qpos) ? sc[kb][i] : -INFINITY;
                    }
            }
            float mx = fmaxf(fmaxf(sc[0][0], sc[1][0]), fmaxf(sc[2][0], sc[3][0]));
#pragma unroll
            for (int i = 1; i < 16; ++i) mx = fmaxf(mx, fmaxf(fmaxf(sc[0][i], sc[1][i]), fmaxf(sc[2][i], sc[3][i])));
            mx = fmaxf(mx, __shfl_xor(mx, 32));
            const float mn = fmaxf(m, mx), alpha = fexp2(m - mn);
            m = mn;
            float ps = 0.f;
#pragma unroll
            for (int kb = 0; kb < 4; ++kb)
#pragma unroll
                for (int i = 0; i < 16; ++i) { sc[kb][i] = fexp2(sc[kb][i] - mn); ps += sc[kb][i]; }
            l = l * alpha + ps;
#pragma unroll
            for (int db = 0; db < NDB; ++db)
#pragma unroll
                for (int i = 0; i < 16; ++i) o[db][i] *= alpha;
            const char* vp = st + KB + q * VS + h * 16;
#pragma unroll
            for (int kb = 0; kb < 4; ++kb) {
                if (k0 + kb * 32 <= qw0 + 31) {
                    u32x4 pa, pb;
                    pa.x = pk2(sc[kb][0], sc[kb][1]);  pa.y = pk2(sc[kb][2], sc[kb][3]);   pa.z = pk2(sc[kb][4], sc[kb][5]);   pa.w = pk2(sc[kb][6], sc[kb][7]);
                    pb.x = pk2(sc[kb][8], sc[kb][9]);  pb.y = pk2(sc[kb][10], sc[kb][11]); pb.z = pk2(sc[kb][12], sc[kb][13]); pb.w = pk2(sc[kb][14], sc[kb][15]);
                    bf16x8 vf[2][NDB];
#pragma unroll
                    for (int gg = 0; gg < 2; ++gg)
#pragma unroll
                        for (int db = 0; db < NDB; ++db) vf[gg][db] = *(const bf16x8*)(vp + db * 32 * VS + (kb * 2 + gg) * 32);
#pragma unroll
                    for (int db = 0; db < NDB; ++db) { o[db] = MFMA(vf[0][db], __builtin_bit_cast(bf16x8, pa), o[db]); o[db] = MFMA(vf[1][db], __builtin_bit_cast(bf16x8, pb), o[db]); }
                }
            }
        }
        if (kt + 1 < ntiles) lwrite(smem + ((kt + 1) & 1) * STAGE);
        __syncthreads();
    }
    const float lt = l + __shfl_xor(l, 32);
    const float inv = 1.0f / lt;
    const int qi = w * 32 + q;
    {
        constexpr int OS = DV * 2 + 16;
        char* orow = smem + qi * OS + 8 * h;
#pragma unroll
        for (int db = 0; db < NDB; ++db)
#pragma unroll
            for (int g = 0; g < 4; ++g) {
                u32x2 v; v.x = pk2(o[db][4 * g] * inv, o[db][4 * g + 1] * inv); v.y = pk2(o[db][4 * g + 2] * inv, o[db][4 * g + 3] * inv);
                *(u32x2*)(orow + (db * 32 + g * 8) * 2) = v;
            }
        __syncthreads();
        const int t2 = tid(), c = t2 & 7;
        const long tok0 = (long)e1 * 2048 + q0;
#pragma unroll
        for (int i = 0; i < 4; ++i) {
            const int rr = (t2 >> 3) + 64 * i;
            float ov[8], zv[8], y[8];
            unpack8(*(const u32x4*)(smem + rr * OS + c * 16), ov);
            unpack8(*(const u32x4*)(p.zb + (tok0 + rr) * DM + e2 * DV + c * 8), zv);
#pragma unroll
            for (int j = 0; j < 8; ++j) y[j] = ov[j] * silu(zv[j]);
            *(u32x4*)(p.y2 + (tok0 + rr) * DM + e2 * DV + c * 8) = pack8(y);
        }
        __syncthreads();
    }
}

DI void attn_unit_b15(const Params& p, char* smem, const bf16_t* __restrict__ Q, const bf16_t* __restrict__ K, const bf16_t* __restrict__ Kr, const bf16_t* __restrict__ Vt,
                      int q0, int ntiles  , int e1, int e2) {
    constexpr int DQK = 96, DV = 64;
    constexpr int KS = DQK * 2 + 16, VS = 144;
    constexpr int KB = 64 * KS, VB = DV * VS, STAGE = KB + VB;
    constexpr int NS = DQK / 16, NDB = DV / 32;
    static_assert(3 * STAGE <= SMEM_BYTES, "attention-B LDS");
    const int t = tid(), lane = t & 63, w = t >> 6, q = lane & 31, h = lane >> 5;
    bf16x8 qf[NS];
    {
        const bf16_t* qp = Q + (long)(w * 32 + q) * DQK + 8 * h;
#pragma unroll
        for (int s = 0; s < NS; ++s) qf[s] = *(const bf16x8*)(qp + 16 * s);
    }
    const int i1 = t + NTHR;
    const int kr0 = t / 12, kc0 = t - kr0 * 12, kr1 = i1 / 12, kc1 = i1 - kr1 * 12;
    const bool has1 = i1 < 768;
    const int vd = t >> 3, vc = t & 7;
    const int vwo = KB + vd * VS + ((vc >> 1) * 16 + 4 * (vc & 1)) * 2;
    u32x4 rk0, rk1, rv0;
    auto gload = [&](int k0) {
        rk0 = kc0 < 8 ? *(const u32x4*)(K + (long)(k0 + kr0) * 64 + kc0 * 8) : *(const u32x4*)(Kr + (long)(k0 + kr0) * 32 + (kc0 - 8) * 8);
        if (has1) rk1 = kc1 < 8 ? *(const u32x4*)(K + (long)(k0 + kr1) * 64 + kc1 * 8) : *(const u32x4*)(Kr + (long)(k0 + kr1) * 32 + (kc1 - 8) * 8);
        rv0 = *(const u32x4*)(Vt + (long)vd * 2048 + k0 + vc * 8);
    };
    auto lwrite = [&](char* st) {
        *(u32x4*)(st + kr0 * KS + kc0 * 16) = rk0;
        if (has1) *(u32x4*)(st + kr1 * KS + kc1 * 16) = rk1;
        u32x2 a = {rv0.x, rv0.y}, b = {rv0.z, rv0.w};
        *(u32x2*)(st + vwo) = a; *(u32x2*)(st + vwo + 16) = b;
    };
    const int qw0 = q0 + w * 32;
    auto qk = [&](const char* st, int k0, f32x16& a0, f32x16& a1) {
#pragma unroll
        for (int i = 0; i < 16; ++i) { a0[i] = 0.f; a1[i] = 0.f; }
        const char* kp = st + q * KS + h * 16;
        bf16x8 kfa[NS], kfb[NS];
#pragma unroll
        for (int s = 0; s < NS; ++s) kfa[s] = *(const bf16x8*)(kp + s * 32);
#pragma unroll
        for (int s = 0; s < NS; ++s) kfb[s] = *(const bf16x8*)(kp + 32 * KS + s * 32);
#pragma unroll
        for (int s = 0; s < NS; ++s) { a0 = MFMA(kfa[s], qf[s], a0); a1 = MFMA(kfb[s], qf[s], a1); }
    };
    auto mask = [&](int k0, f32x16& a0, f32x16& a1) {
        const int qpos = qw0 + q;
#pragma unroll
        for (int i = 0; i < 16; ++i) {
            const int key = k0 + (i & 3) + 8 * (i >> 2) + 4 * h;
            a0[i] = (key <= qpos) ? a0[i] : -INFINITY; a1[i] = (key + 32 <= qpos) ? a1[i] : -INFINITY;
        }
    };
    float m = -1e30f, l = 0.f;
    f32x16 o[NDB];
#pragma unroll
    for (int db = 0; db < NDB; ++db)
#pragma unroll
        for (int i = 0; i < 16; ++i) o[db][i] = 0.f;
    auto finish = [&](const char* st, f32x16& s0, f32x16& s1) {
        float mx = fmaxf(s0[0], s1[0]);
#pragma unroll
        for (int i = 1; i < 16; ++i) mx = fmaxf(mx, fmaxf(s0[i], s1[i]));
        mx = fmaxf(mx, __shfl_xor(mx, 32));
        const float mn = fmaxf(m, mx), alpha = fexp2(m - mn);
        m = mn;
        float ps = 0.f;
#pragma unroll
        for (int i = 0; i < 16; ++i) { s0[i] = fexp2(s0[i] - mn); s1[i] = fexp2(s1[i] - mn); ps += s0[i] + s1[i]; }
        l = l * alpha + ps;
#pragma unroll
        for (int db = 0; db < NDB; ++db)
#pragma unroll
            for (int i = 0; i < 16; ++i) o[db][i] *= alpha;
        const char* vp = st + KB + q * VS + h * 16;
        u32x4 pp[4];
        pp[0].x = pk2(s0[0], s0[1]);  pp[0].y = pk2(s0[2], s0[3]);   pp[0].z = pk2(s0[4], s0[5]);   pp[0].w = pk2(s0[6], s0[7]);
        pp[1].x = pk2(s0[8], s0[9]);  pp[1].y = pk2(s0[10], s0[11]); pp[1].z = pk2(s0[12], s0[13]); pp[1].w = pk2(s0[14], s0[15]);
        pp[2].x = pk2(s1[0], s1[1]);  pp[2].y = pk2(s1[2], s1[3]);   pp[2].z = pk2(s1[4], s1[5]);   pp[2].w = pk2(s1[6], s1[7]);
        pp[3].x = pk2(s1[8], s1[9]);  pp[3].y = pk2(s1[10], s1[11]); pp[3].z = pk2(s1[12], s1[13]); pp[3].w = pk2(s1[14], s1[15]);
        bf16x8 vf[4][NDB];
#pragma unroll
        for (int g = 0; g < 4; ++g)
#pragma unroll
            for (int db = 0; db < NDB; ++db) vf[g][db] = *(const bf16x8*)(vp + db * 32 * VS + g * 32);
#pragma unroll
        for (int g = 0; g < 4; ++g)
#pragma unroll
            for (int db = 0; db < NDB; ++db) o[db] = MFMA(vf[g][db], __builtin_bit_cast(bf16x8, pp[g]), o[db]);
    };
    gload(0); lwrite(smem);
    if (ntiles > 1) gload(64);
    __syncthreads();
    f32x16 c0, c1, n0, n1;
    qk(smem, 0, c0, c1);
    if (63 > qw0) mask(0, c0, c1);
    if (ntiles > 1) lwrite(smem + STAGE);
    __syncthreads();
    for (int kt = 0; kt < ntiles; ++kt) {
        const char* stc = smem + (kt % 3) * STAGE;
        const char* stn = smem + ((kt + 1) % 3) * STAGE;
        const int k0 = kt * 64, k1 = k0 + 64;
        if (kt + 2 < ntiles) gload(k1 + 64);
        __builtin_amdgcn_sched_barrier(0);
        const bool nc = k0 <= qw0 + 31;
        const bool nn = (kt + 1 < ntiles) && (k1 <= qw0 + 31);
        if (nc && nn) {
            qk(stn, k1, n0, n1);
            finish(stc, c0, c1);
        } else if (nc) {
            finish(stc, c0, c1);
        }
        if (nn && (k1 + 63 > qw0)) mask(k1, n0, n1);
        if (kt + 2 < ntiles) lwrite(smem + ((kt + 2) % 3) * STAGE);
        __syncthreads();
#pragma unroll
        for (int i = 0; i < 16; ++i) { c0[i] = n0[i]; c1[i] = n1[i]; }
    }
    const float lt = l + __shfl_xor(l, 32);
    const float inv = 1.0f / lt;
    const int qi = w * 32 + q;
    {
        constexpr int OS = DV * 2 + 16;
        char* orow = smem + qi * OS + 8 * h;
#pragma unroll
        for (int db = 0; db < NDB; ++db)
#pragma unroll
            for (int g = 0; g < 4; ++g) {
                u32x2 v; v.x = pk2(o[db][4 * g] * inv, o[db][4 * g + 1] * inv); v.y = pk2(o[db][4 * g + 2] * inv, o[db][4 * g + 3] * inv);
                *(u32x2*)(orow + (db * 32 + g * 8) * 2) = v;
            }
        __syncthreads();
        const int t2 = tid(), c = t2 & 7;
        const long tok0 = (long)e1 * 2048 + q0;
#pragma unroll
        for (int i = 0; i < 4; ++i) {
            const int rr = (t2 >> 3) + 64 * i;
            float ov[8], zv[8], y[8];
            unpack8(*(const u32x4*)(smem + rr * OS + c * 16), ov);
            unpack8(*(const u32x4*)(p.zb + (tok0 + rr) * DM + e2 * DV + c * 8), zv);
#pragma unroll
            for (int j = 0; j < 8; ++j) y[j] = ov[j] * silu(zv[j]);
            *(u32x4*)(p.y2 + (tok0 + rr) * DM + e2 * DV + c * 8) = pack8(y);
        }
        __syncthreads();
    }
}

DI void phase_attn_b(const Params& p, char* smem) {
    const int CB = p.CB;
    const long nbh = (long)CB * 16, total = nbh * 8;
    for (long L = bidx(); L < total; L += gridDim.x) {
        const long bh = L % nbh; const int qb = 7 - (int)(L / nbh);
        const int bl = (int)(bh >> 4), head = (int)(bh & 15);
        attn_unit_b15(p, smem, p.Qb + (bh * 2048 + qb * 256) * 96, p.Kb + bh * 2048 * 64, p.krope + (long)bl * 2048 * 32, p.VbT + bh * 64 * 2048, qb * 256, 4 * (qb + 1), bl, head);
    }
}

DI void phase_pre(const Params& p, int b0) {
    const int NT = p.CB * 2048;
    const long gt = (long)bidx() * NTHR + tid(), nth = (long)gridDim.x * NTHR;
    for (long idx = gt; idx < (long)NT * 16; idx += nth) {
        const int tokc = (int)(idx >> 4), f = (int)(idx & 15);
        const float ps = (float)p.pos[(long)b0 * 2048 + tokc];
        const float e = (float)f * 0.0625f;
        const float ia = 1.0f / powf(500000.0f, e), ib = 1.0f / powf(10000.0f, e);
        const float aa = ps * ia, ab = ps * ib;
        p.cosA[idx] = cosf(aa); p.sinA[idx] = sinf(aa); p.cosB[idx] = cosf(ab); p.sinB[idx] = sinf(ab);
    }
    const int lane = tid() & 63;
    const int gw = bidx() * 8 + (tid() >> 6), nw = gridDim.x * 8;
    for (int row = gw; row < NT; row += nw) {
        const float* xp = p.x + ((long)b0 * 2048 + row) * DM + lane * 4;
        f32x4 v[4]; float ss = 0.f;
#pragma unroll
        for (int i = 0; i < 4; ++i) { v[i] = *(const f32x4*)(xp + i * 256); ss += v[i].x * v[i].x + v[i].y * v[i].y + v[i].z * v[i].z + v[i].w * v[i].w; }
        ss = wave_sum(ss);
        const float rstd = rsqrtf(ss * (1.0f / 1024.0f) + EPS);
#pragma unroll
        for (int i = 0; i < 4; ++i) {
            const f32x4 g = *(const f32x4*)(p.a_pre + i * 256 + lane * 4);
            u32x2 o; o.x = pk2(v[i].x * rstd * g.x, v[i].y * rstd * g.y); o.y = pk2(v[i].z * rstd * g.z, v[i].w * rstd * g.w);
            *(u32x2*)(p.hn0 + (long)row * DM + i * 256 + lane * 4) = o;
        }
    }
}

DI void phase_merge(const Params& p) {
    const int NT = p.CB * 2048;
    const long gt = (long)bidx() * NTHR + tid(), nth = (long)gridDim.x * NTHR;
    for (long idx = gt; idx < (long)NT * 128; idx += nth) {
        const long tok = idx >> 7; const int c = (int)(idx & 127), head = c >> 4;
        const float l0 = p.La[((long)0 * NT + tok) * 8 + head], l1 = p.La[((long)1 * NT + tok) * 8 + head], l2 = p.La[((long)2 * NT + tok) * 8 + head];
        const float mx = fmaxf(l0, fmaxf(l1, l2));
        float w0 = fexp2(l0 - mx), w1 = fexp2(l1 - mx), w2 = fexp2(l2 - mx);
        const float inv = 1.0f / (w0 + w1 + w2);
        w0 *= inv; w1 *= inv; w2 *= inv;
        float a[8], b[8], cc[8], z[8], y[8];
        unpack8(*(const u32x4*)(p.Oa + ((long)0 * NT + tok) * DM + c * 8), a);
        unpack8(*(const u32x4*)(p.Oa + ((long)1 * NT + tok) * DM + c * 8), b);
        unpack8(*(const u32x4*)(p.Oa + ((long)2 * NT + tok) * DM + c * 8), cc);
        unpack8(*(const u32x4*)(p.Za + tok * DM + c * 8), z);
#pragma unroll
        for (int j = 0; j < 8; ++j) y[j] = (w0 * a[j] + w1 * b[j] + w2 * cc[j]) * silu(z[j]);
        *(u32x4*)(p.hn0 + tok * DM + c * 8) = pack8(y);
    }
}

DI void phase_post_a(const Params& p, int b0) {
    const int NT = p.CB * 2048;
    const int lane = tid() & 63;
    const int gw = bidx() * 8 + (tid() >> 6), nw = gridDim.x * 8;
    for (int row = gw; row < NT; row += nw) {
        const long grow = (long)b0 * 2048 + row;
        float y[16]; float ss = 0.f;
#pragma unroll
        for (int i = 0; i < 2; ++i) {
            float f[8]; unpack8(*(const u32x4*)(p.Za + (long)row * DM + i * 512 + lane * 8), f);
#pragma unroll
            for (int j = 0; j < 8; ++j) { y[8 * i + j] = f[j]; ss += f[j] * f[j]; }
        }
        ss = wave_sum(ss);
        const float rstd = rsqrtf(ss * (1.0f / 1024.0f) + EPS);
        float hv[16]; float s2 = 0.f;
#pragma unroll
        for (int i = 0; i < 2; ++i)
#pragma unroll
            for (int k = 0; k < 2; ++k) {
                const int col = i * 512 + lane * 8 + 4 * k;
                const f32x4 xx = *(const f32x4*)(p.x + grow * DM + col), gg = *(const f32x4*)(p.a_post + col);
                f32x4 hh;
                hh.x = xx.x + y[8 * i + 4 * k] * rstd * gg.x; hh.y = xx.y + y[8 * i + 4 * k + 1] * rstd * gg.y;
                hh.z = xx.z + y[8 * i + 4 * k + 2] * rstd * gg.z; hh.w = xx.w + y[8 * i + 4 * k + 3] * rstd * gg.w;
                hv[8 * i + 4 * k] = hh.x; hv[8 * i + 4 * k + 1] = hh.y; hv[8 * i + 4 * k + 2] = hh.z; hv[8 * i + 4 * k + 3] = hh.w;
                s2 += hh.x * hh.x + hh.y * hh.y + hh.z * hh.z + hh.w * hh.w;
            }
        s2 = wave_sum(s2);
        if (lane == 0) p.ssq[row] = 0.f;
        const float r2 = rsqrtf(s2 * (1.0f / 1024.0f) + EPS);
#pragma unroll
        for (int i = 0; i < 2; ++i) {
            float a[8];
#pragma unroll
            for (int j = 0; j < 8; ++j) a[j] = hv[8 * i + j] * r2;
            *(u32x4*)(p.hn1 + (long)row * DM + i * 512 + lane * 8) = pack8(a);
        }
    }
}

DI void phase_latent(const Params& p) {
    const int NT = p.CB * 2048;
    const int lane = tid() & 63;
    const int gw = bidx() * 8 + (tid() >> 6), nw = gridDim.x * 8;
    for (int row = gw; row < NT; row += nw) {
        const bf16_t* cr = p.ckr + (long)row * 288;
        {
            const u32x2 v = *(const u32x2*)(cr + lane * 4);
            const float f0 = bflo(v.x), f1 = bfhi(v.x), f2 = bflo(v.y), f3 = bfhi(v.y);
            float ss = wave_sum(f0 * f0 + f1 * f1 + f2 * f2 + f3 * f3);
            const float rstd = rsqrtf(ss * (1.0f / 256.0f) + EPS);
            const f32x4 g = *(const f32x4*)(p.kv_lat + lane * 4);
            u32x2 o; o.x = pk2(f0 * rstd * g.x, f1 * rstd * g.y); o.y = pk2(f2 * rstd * g.z, f3 * rstd * g.w);
            *(u32x2*)(p.ckvn + (long)row * 256 + lane * 4) = o;
        }
        {
            const int head = lane >> 2, part = lane & 3;
            const bool lo = part < 2;
            const u32x4 own = *(const u32x4*)(cr + 256 + part * 8), par = *(const u32x4*)(cr + 256 + (part ^ 2) * 8);
            const u32x4 v = rope_chunk(own, par, p.cosB + (long)row * 16 + (part & 1) * 8, p.sinB + (long)row * 16 + (part & 1) * 8, lo);
            const int bl = row >> 11, tt = row & 2047;
            *(u32x4*)(p.Kb + ((long)(bl * 16 + head) * 2048 + tt) * 96 + 64 + part * 8) = v;
        }
        {
            float f[8]; float ss = 0.f;
            if (lane < 48) {
                unpack8(*(const u32x4*)(p.cq + (long)row * 384 + lane * 8), f);
#pragma unroll
                for (int j = 0; j < 8; ++j) ss += f[j] * f[j];
            } else {
#pragma unroll
                for (int j = 0; j < 8; ++j) f[j] = 0.f;
            }
            ss = wave_sum(ss);
            const float rstd = rsqrtf(ss * (1.0f / 384.0f) + EPS);
            if (lane < 48) {
                const f32x4 g0 = *(const f32x4*)(p.b_qn + lane * 8), g1 = *(const f32x4*)(p.b_qn + lane * 8 + 4);
                float o[8] = {f[0] * rstd * g0.x, f[1] * rstd * g0.y, f[2] * rstd * g0.z, f[3] * rstd * g0.w, f[4] * rstd * g1.x, f[5] * rstd * g1.y, f[6] * rstd * g1.z, f[7] * rstd * g1.w};
                *(u32x4*)(p.cqn + (long)row * 384 + lane * 8) = pack8(o);
            }
        }
    }
}

DI void phase_final(const Params& p, int b0) {
    const int NT = p.CB * 2048;
    const int lane = tid() & 63;
    const int gw = bidx() * 8 + (tid() >> 6), nw = gridDim.x * 8;
    for (int row = gw; row < NT; row += nw) {
        const long grow = (long)b0 * 2048 + row;
        float ya[16], yb[16]; float sa = 0.f, sb = 0.f;
#pragma unroll
        for (int i = 0; i < 2; ++i) {
            float f[8], g[8];
            unpack8(*(const u32x4*)(p.Za + (long)row * DM + i * 512 + lane * 8), f);
            unpack8(*(const u32x4*)(p.yB + (long)row * DM + i * 512 + lane * 8), g);
#pragma unroll
            for (int j = 0; j < 8; ++j) { ya[8 * i + j] = f[j]; sa += f[j] * f[j]; yb[8 * i + j] = g[j]; sb += g[j] * g[j]; }
        }
        sa = wave_sum(sa); sb = wave_sum(sb);
        const float ra = rsqrtf(sa * (1.0f / 1024.0f) + EPS), rb = rsqrtf(sb * (1.0f / 1024.0f) + EPS);
#pragma unroll
        for (int i = 0; i < 2; ++i)
#pragma unroll
            for (int k = 0; k < 2; ++k) {
                const int col = i * 512 + lane * 8 + 4 * k;
                const f32x4 xx = *(const f32x4*)(p.x + grow * DM + col), ga = *(const f32x4*)(p.a_post + col), gb = *(const f32x4*)(p.b_post + col);
                f32x4 hh;
                hh.x = (xx.x + ya[8 * i + 4 * k] * ra * ga.x) + yb[8 * i + 4 * k] * rb * gb.x;
                hh.y = (xx.y + ya[8 * i + 4 * k + 1] * ra * ga.y) + yb[8 * i + 4 * k + 1] * rb * gb.y;
                hh.z = (xx.z + ya[8 * i + 4 * k + 2] * ra * ga.z) + yb[8 * i + 4 * k + 2] * rb * gb.z;
                hh.w = (xx.w + ya[8 * i + 4 * k + 3] * ra * ga.w) + yb[8 * i + 4 * k + 3] * rb * gb.w;
                *(f32x4*)(p.out + grow * DM + col) = hh;
            }
    }
}

__global__ void __launch_bounds__(512) yoco_fwd(KParams kp) {
    extern __shared__ __attribute__((aligned(16))) char dsm[];
    char* smem = dsm;
    uint4* xbw = (uint4*)(dsm + SMEM_BYTES);
    if (threadIdx.x == 0) *xbw = make_uint4(0u, 0u, 0u, 0u);
    __syncthreads();
    XcdBarrier bar = xcd_barrier_post(kp.bar, (volatile LAS unsigned*)xbw);
    if (kp.magic == 0x5eed1234) cg::this_grid().sync();

    {
        const Params p = derive(kp);
        transpose_weight(p.a_w_in, p.WaT, 1024, 10240, 10240, nullptr, smem);
        transpose_weight(p.a_w_out, p.WaoT, 1024, 1024, 1024, nullptr, smem);
        transpose_weight(p.kv_w_down, p.WdT, 1024, 288, 288, p.kv_norm, smem);
        transpose_weight(p.b_w_in, p.WdT + 288 * 1024, 1024, 1408, 1504, p.b_pre, smem);
        transpose_weight(p.kv_w_up, p.WkvuT, 256, 2048, 2048, nullptr, smem);
        transpose_weight(p.b_w_q_up, p.WquT, 384, 1536, 1536, p.b_qn, smem);
        transpose_weight(p.b_w_out, p.WboT, 1024, 1024, 1024, nullptr, smem);
    }
#define PH(call) do { const Params p = derive(kp); call; } while (0)
    for (int ch = 0; ch < kp.nchunks; ++ch) {
        const int b0 = ch * kp.CB;
        PH(phase_pre(p, b0));                                        xcd_barrier(bar);
        PH(phase_gemm_a_in(p, smem));                                xcd_barrier(bar);
        PH(phase_attn_a(p, smem));                                   xcd_barrier(bar);
        PH(phase_merge(p));                                          xcd_barrier(bar);
        PH(phase_gemm_plain(p, smem, p.hn0, p.WaoT, p.Za));          xcd_barrier(bar);
        PH(phase_post_a(p, b0));                                     xcd_barrier(bar);
        PH(phase_gemm_down(p, smem));                                xcd_barrier(bar);
        PH(phase_gemm_up(p, smem));                                  xcd_barrier(bar);
        PH(phase_attn_b(p, smem));                                   xcd_barrier(bar);
        PH(phase_gemm_plain(p, smem, p.y2, p.WboT, p.yB));           xcd_barrier(bar);
        PH(phase_final(p, b0));
    }
}

extern "C" void kernel_launch(void* const* d_in, const int* in_sizes, int n_in, void* d_out, int out_size, void* d_ws, size_t ws_size, hipStream_t stream) {
    (void)in_sizes; (void)n_in; (void)out_size;
    static int grid_blocks = 0;
    if (!grid_blocks) {
        int dev = 0, cus = 0, per_cu = 0;
        (void)hipGetDevice(&dev);
        (void)hipDeviceGetAttribute(&cus, hipDeviceAttributeMultiprocessorCount, dev);
        (void)hipFuncSetAttribute((const void*)yoco_fwd, hipFuncAttributeMaxDynamicSharedMemorySize, SMEM_BYTES + 16);
        (void)hipOccupancyMaxActiveBlocksPerMultiprocessor(&per_cu, yoco_fwd, NTHR, SMEM_BYTES + 16);
        if (per_cu > 1) per_cu = 1;
        if (per_cu < 1) per_cu = 1;
        grid_blocks = cus * per_cu;
    }
    KParams p{};
    p.x = (const float*)d_in[0]; p.pos = (const int*)d_in[1]; p.a_pre = (const float*)d_in[2]; p.a_w_in = (const float*)d_in[3];
    p.a_w_out = (const float*)d_in[4]; p.a_post = (const float*)d_in[5]; p.kv_norm = (const float*)d_in[6]; p.kv_w_down = (const float*)d_in[7];
    p.kv_lat = (const float*)d_in[8]; p.kv_w_up = (const float*)d_in[9]; p.b_pre = (const float*)d_in[10]; p.b_w_in = (const float*)d_in[11];
    p.b_qn = (const float*)d_in[12]; p.b_w_q_up = (const float*)d_in[13]; p.b_w_out = (const float*)d_in[14]; p.b_post = (const float*)d_in[15];
    p.out = (float*)d_out;
    char* base = (char*)d_ws;
    p.bar = (unsigned*)base;
    p.wbase = (bf16_t*)(base + 16384);
    const size_t wbytes = ((size_t)10240 * 1024 + 1024 * 1024 + 1792 * 1024 + 2048 * 256 + 1536 * 384 + 1024 * 1024) * 2;
    const size_t fixed = 16384 + wbytes;
    int CB = NBATCH;
    const size_t per_tok = 4 * 64 + 2048 + 2048 + 6144 + 96 + 18432;
    while (CB > 4 && fixed + (size_t)CB * 2048 * per_tok + 65536 > ws_size) CB >>= 1;
    const size_t NT = (size_t)CB * 2048;
    char* c = base + fixed;
    p.tbase = (float*)c; c += NT * 256;
    p.abase = (bf16_t*)c; c += NT * (2048 + 2048 + 6144 + 96);
    p.rbase = (bf16_t*)c;
    p.CB = CB; p.nchunks = NBATCH / CB; p.magic = 0; p.pad = 0;

    (void)hipMemsetAsync(p.bar, 0, 16384, stream);
    void* args[] = {&p};
    hipError_t e = hipLaunchCooperativeKernel((void*)yoco_fwd, dim3(grid_blocks), dim3(NTHR), args, SMEM_BYTES + 16, stream);
    if (e != hipSuccess) fprintf(stderr, "cooperative launch failed: %s (grid %d)\n", hipGetErrorString(e), grid_blocks);
}
```

```cpp
#include <hip/hip_runtime.h>
#include <hip/hip_cooperative_groups.h>
#include <cstdint>
#include <cstdio>
namespace cg = cooperative_groups;

#define DI __device__ __forceinline__
#define LAS __attribute__((address_space(3)))
typedef unsigned short bf16_t;
typedef short bf16x8 __attribute__((ext_vector_type(8)));
typedef float f32x16 __attribute__((ext_vector_type(16)));
typedef float f32x4 __attribute__((ext_vector_type(4)));
typedef float f32x2 __attribute__((ext_vector_type(2)));
typedef unsigned u32x4 __attribute__((ext_vector_type(4)));
typedef unsigned u32x2 __attribute__((ext_vector_type(2)));
typedef __bf16 bfv2 __attribute__((ext_vector_type(2)));

#define MFMA(a, b, c) __builtin_amdgcn_mfma_f32_32x32x16_bf16((a), (b), (c), 0, 0, 0)

constexpr int T_SEQ = 2048;
constexpr int DM = 1024;
constexpr int NBATCH = 32;
constexpr float QSCALE_A = 0.08838834764831845f * 1.4426950408889634f;
constexpr float QSCALE_B = 0.10206207261596575f * 1.4426950408889634f;
constexpr float LOG2E = 1.4426950408889634f;
constexpr float EPS = 1e-6f;

constexpr int TS = 144;
constexpr int TILE_BYTES = 256 * TS;
constexpr int CS = 528;
constexpr int CSH = 272;
constexpr int NTHR = 512;
constexpr int SMEM_BYTES = 4 * (64 * 272 + 128 * 144);

struct Params {
    const float* x; const int* pos; const float* a_pre; const float* a_w_in; const float* a_w_out; const float* a_post;
    const float* kv_norm; const float* kv_w_down; const float* kv_lat; const float* kv_w_up;
    const float* b_pre; const float* b_w_in; const float* b_qn; const float* b_w_q_up; const float* b_w_out; const float* b_post;
    float* out;
    unsigned* bar;
    bf16_t *WaT, *WaoT, *WdT, *WkvuT, *WquT, *WboT;
    float *cosA, *sinA, *cosB, *sinB;
    bf16_t *hn0, *Za, *Oa; float* La;
    bf16_t *Qa, *Ka, *VaT;
    bf16_t *hn1, *y2, *yB, *ckr, *cq, *zb, *ckvn, *cqn, *Kb, *VbT, *Qb, *krope; float* ssq;
    int CB; int nchunks; int magic; int pad;
};

struct KParams {
    const float* x; const int* pos; const float* a_pre; const float* a_w_in; const float* a_w_out; const float* a_post;
    const float* kv_norm; const float* kv_w_down; const float* kv_lat; const float* kv_w_up;
    const float* b_pre; const float* b_w_in; const float* b_qn; const float* b_w_q_up; const float* b_w_out; const float* b_post;
    float* out;
    unsigned* bar;
    bf16_t* wbase; float* tbase; bf16_t* abase; bf16_t* rbase;
    int CB; int nchunks; int magic; int pad;
};
__device__ __forceinline__ Params derive(const KParams& k) {
    Params p;
    p.x = k.x; p.pos = k.pos; p.a_pre = k.a_pre; p.a_w_in = k.a_w_in; p.a_w_out = k.a_w_out; p.a_post = k.a_post;
    p.kv_norm = k.kv_norm; p.kv_w_down = k.kv_w_down; p.kv_lat = k.kv_lat; p.kv_w_up = k.kv_w_up;
    p.b_pre = k.b_pre; p.b_w_in = k.b_w_in; p.b_qn = k.b_qn; p.b_w_q_up = k.b_w_q_up; p.b_w_out = k.b_w_out; p.b_post = k.b_post;
    p.out = k.out; p.bar = k.bar;
    long NT = (long)k.CB * 2048;
    asm volatile("" : "+s"(NT));
    p.WaT = k.wbase; p.WaoT = p.WaT + 10240L * 1024; p.WdT = p.WaoT + 1024L * 1024; p.WkvuT = p.WdT + 1792L * 1024; p.WquT = p.WkvuT + 2048L * 256; p.WboT = p.WquT + 1536L * 384;
    p.cosA = k.tbase; p.sinA = p.cosA + NT * 16; p.cosB = p.cosA + NT * 32; p.sinB = p.cosA + NT * 48;
    p.hn0 = k.abase; p.Za = p.hn0 + NT * 1024; p.Oa = p.hn0 + NT * 2048; p.La = (float*)(p.hn0 + NT * 5120);
    p.Qa = k.rbase; p.Ka = p.Qa + NT * 3072; p.VaT = p.Qa + NT * 6144;
    p.hn1 = k.rbase; p.y2 = p.hn1; p.yB = p.hn1 + NT * 1024; p.ckr = p.hn1 + NT * 2048; p.cq = p.hn1 + NT * 2336; p.zb = p.hn1 + NT * 2720;
    p.ckvn = p.hn1 + NT * 3744; p.cqn = p.hn1 + NT * 4000; p.Kb = p.hn1 + NT * 4384; p.VbT = p.hn1 + NT * 5920; p.Qb = p.hn1 + NT * 6944;
    p.krope = p.hn1 + NT * 8480; p.ssq = (float*)(p.hn1 + NT * 8512);
    p.CB = k.CB; p.nchunks = k.nchunks; p.magic = k.magic; p.pad = 0;
    return p;
}

DI unsigned pk2(float lo, float hi) { f32x2 v = {lo, hi}; bfv2 b = __builtin_convertvector(v, bfv2); return __builtin_bit_cast(unsigned, b); }
DI float bflo(unsigned u) { return __uint_as_float(u << 16); }
DI float bfhi(unsigned u) { return __uint_as_float(u & 0xffff0000u); }
DI unsigned short f2bf(float x) { return (unsigned short)(pk2(x, 0.f) & 0xffffu); }
DI float wave_sum(float v) {
#pragma unroll
    for (int o = 32; o > 0; o >>= 1) v += __shfl_xor(v, o);
    return v;
}
DI int tid() { int t = threadIdx.x; asm volatile("" : "+v"(t)); return t; }
DI int bidx() { int b = blockIdx.x; asm volatile("" : "+s"(b)); return b; }
DI float fexp2(float x) { return __builtin_amdgcn_exp2f(x); }
DI float silu(float z) { const float e = fexp2(-z * LOG2E); return z * __builtin_amdgcn_rcpf(1.0f + e); }
DI void unpack8(const u32x4& v, float (&f)[8]) {
    f[0] = bflo(v.x); f[1] = bfhi(v.x); f[2] = bflo(v.y); f[3] = bfhi(v.y); f[4] = bflo(v.z); f[5] = bfhi(v.z); f[6] = bflo(v.w); f[7] = bfhi(v.w);
}
DI u32x4 pack8(const float (&f)[8]) { u32x4 v; v.x = pk2(f[0], f[1]); v.y = pk2(f[2], f[3]); v.z = pk2(f[4], f[5]); v.w = pk2(f[6], f[7]); return v; }

#define XB_TMO      128
#define XB_XCNT(j)  (256  + 64 * (j))
#define XB_XSUB(j)  (1280 + 64 * (j))
#define XB_XGEN(j)  (2304 + 64 * (j))
#define XB_TOP      3328
#define XB_TOPGEN   3392
#define XCD_BAR_WORDS 3456
#define XB_SPIN_CAP (1u << 22)
DI unsigned xb_ld(unsigned* p)              { return __hip_atomic_load(p, __ATOMIC_RELAXED, __HIP_MEMORY_SCOPE_AGENT); }
DI unsigned xb_add(unsigned* p, unsigned v) { return __hip_atomic_fetch_add(p, v, __ATOMIC_RELAXED, __HIP_MEMORY_SCOPE_AGENT); }
DI unsigned xb_xcc_id() { return (unsigned)__builtin_amdgcn_s_getreg((3 << 11) | 20) & 0xFu; }
#define XB_SPIN(cond, bar) do { unsigned _sp = 0; while (cond) { __builtin_amdgcn_s_sleep(1); \
    if ((++_sp & 255u) == 0u) { if (xb_ld(&(bar)[XB_TMO])) break; if (_sp > XB_SPIN_CAP) { atomicAdd(&(bar)[XB_TMO], 1u); break; } } } } while (0)
struct XcdBarrier { unsigned* bar; unsigned x; volatile LAS unsigned* st; };
DI XcdBarrier xcd_barrier_post(unsigned* bar, volatile LAS unsigned* st) {
    XcdBarrier b; b.bar = bar; b.x = xb_xcc_id(); b.st = st;
    if (threadIdx.x == 0) (void)xb_add(&bar[XB_XCNT(b.x)], 1u);
    return b;
}
DI void xcd_barrier_complete(unsigned* bar, unsigned x, unsigned& nloc, unsigned& nx) {
    const unsigned G = gridDim.x * gridDim.y * gridDim.z;
    unsigned sum, cnt, mine, sp = 0u;
    for (;;) {
        sum = 0u; cnt = 0u; mine = 0u;
#pragma unroll
        for (unsigned j = 0; j < 16; ++j) { const unsigned c = xb_ld(&bar[XB_XCNT(j)]); sum += c; cnt += (c > 0u) ? 1u : 0u; mine = (j == x) ? c : mine; }
        if (sum == G) break;
        __builtin_amdgcn_s_sleep(1);
        if ((++sp & 255u) == 0u) { if (xb_ld(&bar[XB_TMO])) break; if (sp > XB_SPIN_CAP) { atomicAdd(&bar[XB_TMO], 1u); break; } }
    }
    nloc = mine > 0u ? mine : 1u; nx = cnt > 0u ? cnt : 1u;
}
DI void xcd_barrier(const XcdBarrier& b) {
    asm volatile("s_waitcnt vmcnt(0)" ::: "memory");
    __syncthreads();
    if (threadIdx.x == 0) {
        unsigned* bar = b.bar;
        __builtin_amdgcn_s_waitcnt(0);
        unsigned nloc = b.st[0], nx = b.st[1];
        if (nloc == 0u) { xcd_barrier_complete(bar, b.x, nloc, nx); b.st[0] = nloc; b.st[1] = nx; }
        const unsigned old = xb_add(&bar[XB_XSUB(b.x)], 1u);
        const unsigned gen = old / nloc;
        if (old + 1u == (gen + 1u) * nloc) {
            __builtin_amdgcn_fence(__ATOMIC_RELEASE, "agent");
            asm volatile("s_waitcnt vmcnt(0)" ::: "memory");
            const unsigned og = xb_add(&bar[XB_TOP], 1u);
            const unsigned tg = og / nx;
            if (og + 1u == (tg + 1u) * nx) xb_add(&bar[XB_TOPGEN], 1u);
            else XB_SPIN(xb_ld(&bar[XB_TOPGEN]) == tg, bar);
            __builtin_amdgcn_fence(__ATOMIC_ACQUIRE, "agent");
            xb_add(&bar[XB_XGEN(b.x)], 1u);
            asm volatile("s_waitcnt vmcnt(0)" ::: "memory");
        } else {
            XB_SPIN(xb_ld(&bar[XB_XGEN(b.x)]) == gen, bar);
            __builtin_amdgcn_fence(__ATOMIC_ACQUIRE, "agent");
            asm volatile("s_waitcnt vmcnt(0)" ::: "memory");
        }
    }
    __syncthreads();
}

struct WUnit { const float* src; const float* gain; bf16_t* dst; int K, ldn, n0, k0; bool valid; };
DI void wunit_decode(const Params& p, int u, int lane_n4, WUnit& w) {
    int ntk; const float* W; const float* g = nullptr; bf16_t* D; int N; int K;
    if (u < 1280)      { ntk = 16; W = p.a_w_in;   D = p.WaT;   N = 10240; K = 1024; }
    else if (u < 1408) { u -= 1280; ntk = 16; W = p.a_w_out;  D = p.WaoT;  N = 1024; K = 1024; }
    else if (u < 1632) { u -= 1408; ntk = 16; W = nullptr;    D = p.WdT;   N = 1792; K = 1024; }
    else if (u < 1696) { u -= 1632; ntk = 4;  W = p.kv_w_up;  D = p.WkvuT; N = 2048; K = 256; }
    else if (u < 1768) { u -= 1696; ntk = 6;  W = p.b_w_q_up; D = p.WquT;  N = 1536; K = 384; g = p.b_qn; }
    else               { u -= 1768; ntk = 16; W = p.b_w_out;  D = p.WboT;  N = 1024; K = 1024; }
    const int kt = u % ntk, nt = u / ntk;
    w.K = K; w.k0 = kt << 6; w.n0 = nt << 7; w.dst = D; w.gain = g; w.valid = true; w.ldn = N;
    if (W) { w.src = W + w.n0 + lane_n4; }
    else {
        const int n = w.n0 + lane_n4;
        if (n < 288)       { w.src = p.kv_w_down + n;       w.ldn = 288;  w.gain = p.kv_norm; }
        else if (n < 1696) { w.src = p.b_w_in + (n - 288);  w.ldn = 1408; w.gain = p.b_pre; }
        else               { w.src = nullptr; w.valid = false; }
    }
}
DI void transpose_all(const Params& p, char* smem) {
    constexpr int NUNITS = 1896, TLS = 129;
    float* Tl = (float*)smem;
    const int t = tid();
    const int lk = t >> 5, ln4 = 4 * (t & 31);
    const int G = gridDim.x;
    int u = bidx();
    f32x4 v[4]; float gk[4]; WUnit w;
    auto issue = [&](int uu) {
        wunit_decode(p, uu, ln4, w);
#pragma unroll
        for (int i = 0; i < 4; ++i) {
            const int k = w.k0 + lk + 16 * i;
            v[i] = w.valid ? *(const f32x4*)(w.src + (long)k * w.ldn) : (f32x4){0.f, 0.f, 0.f, 0.f};
            gk[i] = (w.valid && w.gain) ? w.gain[k] : 1.0f;
        }
    };
    if (u < NUNITS) issue(u);
    while (u < NUNITS) {
        const int K = w.K, k0 = w.k0, n0 = w.n0; bf16_t* dst = w.dst;
        __syncthreads();
#pragma unroll
        for (int i = 0; i < 4; ++i) {
            float* r = Tl + (lk + 16 * i) * TLS + ln4;
            r[0] = v[i].x * gk[i]; r[1] = v[i].y * gk[i]; r[2] = v[i].z * gk[i]; r[3] = v[i].w * gk[i];
        }
        const int un = u + G;
        if (un < NUNITS) issue(un);
        __syncthreads();
#pragma unroll
        for (int hh = 0; hh < 2; ++hh) {
            const int n = (t >> 3) + 64 * hh, c = t & 7;
            float f[8];
#pragma unroll
            for (int j = 0; j < 8; ++j) f[j] = Tl[(8 * c + j) * TLS + n];
            *(u32x4*)(dst + (long)(n0 + n) * K + k0 + 8 * c) = pack8(f);
        }
        u = un;
    }
    __syncthreads();
}

DI int lds_byte(int r, int c) { const int st = (r >> 4) * 2 + (c >> 5), rr = r & 15, cc = c & 31, ob = rr * 64 + cc * 2; return st * 1024 + (ob ^ (((ob >> 9) & 1) << 5)); }
DI void stage_rc(int b, int& R, int& C) { const int st = b / 1024, sb = b % 1024, swz = sb ^ (((sb >> 9) & 1) << 5); R = (st >> 1) * 16 + swz / 64; C = (st & 1) * 32 + (swz % 64) / 2; }
#define GLDS(gp, lp) __builtin_amdgcn_global_load_lds((const unsigned*)(gp), (LAS unsigned*)(lp), 16, 0, 0)
#define HTB 16384
DI void gemm_mainloop(const bf16_t* __restrict__ a0, long aoff1, long aoff2, long aoff3,
                      const bf16_t* __restrict__ bp, long b_stride, int K, char* smem, f32x4 (&acc)[2][2][4][2]) {
    const int t = tid(), lane = t & 63, wid = t >> 6, wr = wid >> 2, wc = wid & 3, fr = lane & 15, fq = lane >> 4;
    LAS char* sl = (LAS char*)smem;
    LAS char* lw = sl + t * 16;
    const int intra = (fr * 64 + fq * 16) ^ ((fr >> 3) << 5);
    const LAS char* ra = sl + wr * 8192 + intra;
    const LAS char* rb = sl + 4 * HTB + wc * 4096 + intra;
#define LAUNDER_OFFS asm volatile("" : "+s"(aoff1), "+s"(aoff2), "+s"(aoff3), "+s"(b_stride))
#define STAGE_A(b, h, kt) do { const long _ko = (long)(kt) * 64; GLDS(a0 + (((h) ? aoff2 : 0L) + _ko), lw + ((b) * 2 + (h)) * HTB); GLDS(a0 + (((h) ? aoff3 : aoff1) + _ko), lw + ((b) * 2 + (h)) * HTB + 8192); } while (0)
#define STAGE_B(b, h, kt) do { const long _ko = (long)(kt) * 64 + (long)((h) * 128) * b_stride; GLDS(bp + _ko, lw + (4 + (b) * 2 + (h)) * HTB); GLDS(bp + (_ko + 64 * b_stride), lw + (4 + (b) * 2 + (h)) * HTB + 8192); } while (0)
#define LDA(dst, b, h) _Pragma("unroll") for (int m = 0; m < 4; ++m) _Pragma("unroll") for (int k = 0; k < 2; ++k) dst[m][k] = *(const LAS bf16x8*)(ra + ((b) * 2 + (h)) * HTB + m * 2048 + k * 1024)
#define LDB(dst, b, h) _Pragma("unroll") for (int n = 0; n < 2; ++n) _Pragma("unroll") for (int k = 0; k < 2; ++k) dst[n][k] = *(const LAS bf16x8*)(rb + ((b) * 2 + (h)) * HTB + n * 2048 + k * 1024)
#define MMA(ai, bj, At, Bt) do { __builtin_amdgcn_s_setprio(1); \
    _Pragma("unroll") for (int m = 0; m < 4; ++m) _Pragma("unroll") for (int n = 0; n < 2; ++n) _Pragma("unroll") for (int k = 0; k < 2; ++k) \
        acc[ai][bj][m][n] = __builtin_amdgcn_mfma_f32_16x16x32_bf16(Bt[n][k], At[m][k], acc[ai][bj][m][n], 0, 0, 0); \
    __builtin_amdgcn_s_setprio(0); } while (0)
#define WAIT_V(n) asm volatile("s_waitcnt vmcnt(" #n ")" ::: "memory")
#define WAIT_L(n) asm volatile("s_waitcnt lgkmcnt(" #n ")" ::: "memory")
#define BAR __builtin_amdgcn_s_barrier()
#define SCHED __builtin_amdgcn_sched_barrier(0)
#pragma unroll
    for (int a = 0; a < 2; ++a)
#pragma unroll
        for (int b = 0; b < 2; ++b)
#pragma unroll
            for (int m = 0; m < 4; ++m)
#pragma unroll
                for (int n = 0; n < 2; ++n) acc[a][b][m][n] = (f32x4){0.f, 0.f, 0.f, 0.f};
    bf16x8 At[4][2], B0[2][2], B1[2][2];
    const int nt = K >> 6;
    STAGE_B(0, 0, 0); STAGE_A(0, 0, 0);
    STAGE_B(0, 1, 0); STAGE_A(0, 1, 0);
    if (wr == 1) BAR;
    WAIT_V(4); BAR;
    STAGE_B(1, 0, 1); STAGE_A(1, 0, 1); STAGE_B(1, 1, 1);
    WAIT_V(6); BAR;
    for (int tt = 0; tt < nt - 2; tt += 2) {
        LAUNDER_OFFS;
        LDB(B0, 0, 0); SCHED; LDA(At, 0, 0); STAGE_A(1, 1, tt + 1);
        WAIT_L(8); BAR; WAIT_L(0); MMA(0, 0, At, B0); BAR; SCHED;
        LDB(B1, 0, 1); STAGE_B(0, 0, tt + 2);
        BAR; WAIT_L(0); MMA(0, 1, At, B1); BAR;
        LDA(At, 0, 1); STAGE_A(0, 0, tt + 2);
        BAR; WAIT_L(0); MMA(1, 0, At, B0); BAR; SCHED;
        STAGE_B(0, 1, tt + 2);
        WAIT_V(6); BAR; MMA(1, 1, At, B1); BAR;
        LDB(B0, 1, 0); SCHED; LDA(At, 1, 0); STAGE_A(0, 1, tt + 2);
        WAIT_L(8); BAR; WAIT_L(0); MMA(0, 0, At, B0); BAR; SCHED;
        LDB(B1, 1, 1); STAGE_B(1, 0, tt + 3);
        BAR; WAIT_L(0); MMA(0, 1, At, B1); BAR;
        LDA(At, 1, 1); STAGE_A(1, 0, tt + 3);
        BAR; WAIT_L(0); MMA(1, 0, At, B0); BAR; SCHED;
        STAGE_B(1, 1, tt + 3);
        WAIT_V(6); BAR; MMA(1, 1, At, B1); BAR;
    }
    LAUNDER_OFFS;
    {   LDB(B0, 0, 0); LDA(At, 0, 0); STAGE_A(1, 1, nt - 1);
        BAR; WAIT_L(0); MMA(0, 0, At, B0); BAR;
        LDB(B1, 0, 1); BAR; WAIT_L(0); MMA(0, 1, At, B1); BAR;
        LDA(At, 0, 1); WAIT_V(4); BAR; WAIT_L(0); MMA(1, 0, At, B0); MMA(1, 1, At, B1); BAR; }
    {   LDB(B0, 1, 0); LDA(At, 1, 0); WAIT_V(2); BAR; WAIT_L(0); MMA(0, 0, At, B0); BAR;
        LDB(B1, 1, 1); WAIT_V(0); BAR; WAIT_L(0); MMA(0, 1, At, B1); BAR;
        LDA(At, 1, 1); BAR; WAIT_L(0); MMA(1, 0, At, B0); MMA(1, 1, At, B1); BAR; }
    if (wr == 0) BAR;
    __syncthreads();
}

DI void stage_rm(const f32x4 (&acc)[2][2][4][2], char* lds, int csb, int bjs, int wcoff, int lane, int wr, float sc) {
    const int fr = lane & 15, fq = lane >> 4;
#pragma unroll
    for (int ai = 0; ai < 2; ++ai)
#pragma unroll
        for (int m = 0; m < 4; ++m) {
            char* rowp = lds + (ai * 128 + wr * 64 + m * 16 + fr) * csb + (wcoff + fq * 4) * 2;
#pragma unroll
            for (int bj = 0; bj < 2; ++bj)
#pragma unroll
                for (int n = 0; n < 2; ++n) {
                    const f32x4 v = acc[ai][bj][m][n];
                    u32x2 o; o.x = pk2(v.x * sc, v.y * sc); o.y = pk2(v.z * sc, v.w * sc);
                    *(u32x2*)(rowp + (bj * bjs + n * 16) * 2) = o;
                }
        }
}
DI void stage_tr(const f32x4 (&acc)[2][2][4][2], char* lds, int bjs, int wcoff, int lane, int wr) {
    const int fr = lane & 15, fq = lane >> 4;
#pragma unroll
    for (int ai = 0; ai < 2; ++ai)
#pragma unroll
        for (int m = 0; m < 4; ++m) {
            char* colp = lds + (wcoff + fq * 4) * CS + (ai * 128 + wr * 64 + m * 16 + fr) * 2;
#pragma unroll
            for (int bj = 0; bj < 2; ++bj)
#pragma unroll
                for (int n = 0; n < 2; ++n) {
                    const f32x4 v = acc[ai][bj][m][n];
                    char* q = colp + (bj * bjs + n * 16) * CS;
                    *(unsigned short*)(q) = f2bf(v.x); *(unsigned short*)(q + CS) = f2bf(v.y);
                    *(unsigned short*)(q + 2 * CS) = f2bf(v.z); *(unsigned short*)(q + 3 * CS) = f2bf(v.w);
                }
        }
}
DI u32x4 rope_chunk(const u32x4& own, const u32x4& par, const float* __restrict__ cs, const float* __restrict__ sn, bool lo) {
    float a[8], b[8], o[8];
    unpack8(own, a); unpack8(par, b);
    const f32x4 c0 = *(const f32x4*)cs, c1 = *(const f32x4*)(cs + 4), s0 = *(const f32x4*)sn, s1 = *(const f32x4*)(sn + 4);
    const float cc[8] = {c0.x, c0.y, c0.z, c0.w, c1.x, c1.y, c1.z, c1.w};
    const float ss[8] = {s0.x, s0.y, s0.z, s0.w, s1.x, s1.y, s1.z, s1.w};
    const float sg = lo ? -1.f : 1.f;
#pragma unroll
    for (int j = 0; j < 8; ++j) o[j] = a[j] * cc[j] + sg * b[j] * ss[j];
    return pack8(o);
}
DI u32x4 rope_chunk_v(const u32x4& own, const u32x4& par, const f32x4& c0, const f32x4& c1, const f32x4& s0, const f32x4& s1, bool lo) {
    float a[8], b[8], o[8];
    unpack8(own, a); unpack8(par, b);
    const float cc[8] = {c0.x, c0.y, c0.z, c0.w, c1.x, c1.y, c1.z, c1.w};
    const float ss[8] = {s0.x, s0.y, s0.z, s0.w, s1.x, s1.y, s1.z, s1.w};
    const float sg = lo ? -1.f : 1.f;
#pragma unroll
    for (int j = 0; j < 8; ++j) o[j] = a[j] * cc[j] + sg * b[j] * ss[j];
    return pack8(o);
}
DI void store_rm(const char* lds, bf16_t* __restrict__ dst, long ld) {
    const int t = tid(), c = t & 31;
#pragma unroll
    for (int i = 0; i < 16; ++i) {
        const int rr = (t >> 5) + 16 * i;
        *(u32x4*)(dst + (long)rr * ld + c * 8) = *(const u32x4*)(lds + rr * CS + c * 16);
    }
}

DI void phase_gemm_a_in(const Params& p, char* smem) {
    const int CB = p.CB, MT = CB * 8, mt0 = 0;
    const long total = (long)MT * 40, tpad = (total + 255) & ~255L;
    for (long L = bidx(); L < tpad; L += gridDim.x) {
        const int xcd = (int)(L & 7); const long j = L >> 3;
        const int S = (int)(j >> 5) * 8 + xcd, wi = (int)(j & 31);
        const int sm = S / 10, sn = S - sm * 10;
        const int mtl = sm * 8 + (wi & 7), nt = sn * 4 + (wi >> 3);
        if (mtl >= MT) continue;
        const int mt = mt0 + mtl;
        const int col0 = nt * 256;
        const int bl = mt >> 3, pp0 = (mt & 7) << 8;
        f32x4 acc[2][2][4][2];
        const bool grp = col0 < 9216;
        const int g = grp ? col0 / 3072 : 0, rem = col0 - g * 3072, which = rem >> 10, head0 = (rem & 1023) >> 7;
        const int dsh = 2 * g, Lsh = 11 - dsh, Lm = (2048 >> dsh) - 1;
        {
            int R0, C0; stage_rc(tid() * 16, R0, C0);
            const int ppa = pp0 + R0, tka = ((ppa & Lm) << dsh) + (ppa >> Lsh);
            const int t0u = ((pp0 & Lm) << dsh) + (pp0 >> Lsh), t2u = (((pp0 + 128) & Lm) << dsh) + ((pp0 + 128) >> Lsh);
            const long off1 = (long)(64 << dsh) * DM, off2 = (long)(t2u - t0u) * DM;
            gemm_mainloop(p.hn0 + (long)(bl * 2048 + tka) * DM + C0, off1, off2, off2 + off1, p.WaT + (long)(col0 + R0) * DM + C0, DM, DM, smem, acc);
        }
        const int te = tid(), lane = te & 63, wid = __builtin_amdgcn_readfirstlane(te >> 6), wr = wid >> 2, wc = wid & 3;
        if (grp) {
            const long hb0 = (long)(g * CB + bl) * 8 + head0;
            if (which < 2) {
                if (wc == 0) {
                    const int fr = lane & 15, fq = lane >> 4;
#pragma unroll
                    for (int ai = 0; ai < 2; ++ai) {
                        f32x4 cv[4], sv[4];
#pragma unroll
                        for (int m = 0; m < 4; ++m) {
                            const int pp = pp0 + ai * 128 + wr * 64 + m * 16 + fr;
                            const long tokc = (long)bl * 2048 + ((pp & Lm) << dsh) + (pp >> Lsh);
                            cv[m] = *(const f32x4*)(p.cosA + tokc * 16 + fq * 4); sv[m] = *(const f32x4*)(p.sinA + tokc * 16 + fq * 4);
                        }
#pragma unroll
                        for (int m = 0; m < 4; ++m)
#pragma unroll
                            for (int bj = 0; bj < 2; ++bj) {
                                const f32x4 x1 = acc[ai][bj][m][0], x2 = acc[ai][bj][m][1];
                                acc[ai][bj][m][0] = x1 * cv[m] - x2 * sv[m];
                                acc[ai][bj][m][1] = x2 * cv[m] + x1 * sv[m];
                            }
                    }
                }
                stage_rm(acc, smem, CS, 128, wc * 32, lane, wr, which == 0 ? QSCALE_A : 1.0f);
                __syncthreads();
                const int t2 = tid();
                const int c = t2 & 31, cc = c & 15;
                bf16_t* dst = (which == 0 ? p.Qa : p.Ka) + (hb0 + (c >> 4)) * 2048 * 128 + cc * 8;
#pragma unroll
                for (int i = 0; i < 16; ++i) {
                    const int rr = (t2 >> 5) + 16 * i, pp = pp0 + rr;
                    __builtin_nontemporal_store(*(const u32x4*)(smem + rr * CS + c * 16), (u32x4*)(dst + (long)pp * 128));
                }
            } else {
                stage_tr(acc, smem, 128, wc * 32, lane, wr);
                __syncthreads();
                const int t2 = tid();
                const int c = t2 & 31;
                bf16_t* dst = p.VaT + (hb0 * 128 + (t2 >> 5)) * 2048 + pp0 + c * 8;
                const char* src = smem + (t2 >> 5) * CS + c * 16;
#pragma unroll
                for (int i = 0; i < 16; ++i) __builtin_nontemporal_store(*(const u32x4*)(src + i * 16 * CS), (u32x4*)(dst + (long)i * 16 * 2048));
            }
        } else {
            stage_rm(acc, smem, CS, 128, wc * 32, lane, wr, 1.0f);
            __syncthreads();
            store_rm(smem, p.Za + (long)mt * 256 * DM + (col0 - 9216), DM);
        }
        __syncthreads();
    }
}

DI bool narrow_map(long L, int NTn, int MT, int& mt, int& nt) {
    const int xcd = (int)(L & 7); const long j = L >> 3;
    mt = (int)(j / NTn) * 8 + xcd; nt = (int)(j % NTn);
    return mt < MT;
}

DI void phase_gemm_plain(const Params& p, char* smem, const bf16_t* A, const bf16_t* Wt, bf16_t* O) {
    const int MT = p.CB * 8;
    const long total = (long)MT * 4;
    const int t = tid(), lane = t & 63, wid = t >> 6, wr = wid >> 2, wc = wid & 3;
    int R0, C0; stage_rc(t * 16, R0, C0);
    for (long L = bidx(); L < total; L += gridDim.x) {
        int mt, nt; if (!narrow_map(L, 4, MT, mt, nt)) continue;
        f32x4 acc[2][2][4][2];
        gemm_mainloop(A + (long)(mt * 256 + R0) * DM + C0, 64 * DM, 128 * DM, 192 * DM, Wt + (long)(nt * 256 + R0) * DM + C0, DM, DM, smem, acc);
        stage_rm(acc, smem, CS, 128, wc * 32, lane, wr, 1.0f);
        __syncthreads();
        store_rm(smem, O + (long)mt * 256 * DM + nt * 256, DM);
        __syncthreads();
    }
}

DI void phase_gemm_down(const Params& p, char* smem) {
    const int MT = p.CB * 8;
    const long total = (long)MT * 7;
    const int t = tid(), lane = t & 63, wid = t >> 6, wr = wid >> 2, wc = wid & 3;
    int R0, C0; stage_rc(t * 16, R0, C0);
    for (long L = bidx(); L < total; L += gridDim.x) {
        int mt, nt; if (!narrow_map(L, 7, MT, mt, nt)) continue;
        f32x4 acc[2][2][4][2];
        gemm_mainloop(p.hn1 + (long)(mt * 256 + R0) * DM + C0, 64 * DM, 128 * DM, 192 * DM, p.WdT + (long)(nt * 256 + R0) * DM + C0, DM, DM, smem, acc);
        stage_rm(acc, smem, CS, 128, wc * 32, lane, wr, 1.0f);
        __syncthreads();
        const int t2 = tid();
        const int c = t2 & 31, col = nt * 256 + c * 8;
        if (nt == 0) {
            const f32x4 g0 = *(const f32x4*)(p.kv_lat + col), g1 = *(const f32x4*)(p.kv_lat + col + 4);
#pragma unroll 4
            for (int i = 0; i < 16; ++i) {
                const int rr = (t2 >> 5) + 16 * i;
                float f[8]; unpack8(*(const u32x4*)(smem + rr * CS + c * 16), f);
                float ss = 0.f;
#pragma unroll
                for (int j = 0; j < 8; ++j) ss += f[j] * f[j];
                ss += __shfl_xor(ss, 1); ss += __shfl_xor(ss, 2); ss += __shfl_xor(ss, 4); ss += __shfl_xor(ss, 8); ss += __shfl_xor(ss, 16);
                const float rstd = rsqrtf(ss * (1.0f / 256.0f) + EPS);
                float o[8] = {f[0] * rstd * g0.x, f[1] * rstd * g0.y, f[2] * rstd * g0.z, f[3] * rstd * g0.w, f[4] * rstd * g1.x, f[5] * rstd * g1.y, f[6] * rstd * g1.z, f[7] * rstd * g1.w};
                *(u32x4*)(p.ckvn + (long)(mt * 256 + rr) * 256 + col) = pack8(o);
            }
        } else if (nt <= 2) {
            const bool isr = col < 288, isq = !isr && col < 672;
#pragma unroll
            for (int hf = 0; hf < 4; ++hf) {
                f32x4 tc0[4], tc1[4], ts0[4], ts1[4];
#pragma unroll
                for (int k = 0; k < 4; ++k) {
                    const long tok = (long)mt * 256 + (t2 >> 5) + 16 * (hf * 4 + k);
                    const float* cs = p.cosB + tok * 16 + (c & 1) * 8; const float* sn = p.sinB + tok * 16 + (c & 1) * 8;
                    tc0[k] = *(const f32x4*)cs; tc1[k] = *(const f32x4*)(cs + 4); ts0[k] = *(const f32x4*)sn; ts1[k] = *(const f32x4*)(sn + 4);
                }
#pragma unroll
                for (int k = 0; k < 4; ++k) {
                    const int rr = (t2 >> 5) + 16 * (hf * 4 + k);
                    const long tok = (long)mt * 256 + rr;
                    u32x4 v = *(const u32x4*)(smem + rr * CS + c * 16);
                    float ss = 0.f;
                    if (isr) {
                        const u32x4 pv = *(const u32x4*)(smem + rr * CS + (c ^ 2) * 16);
                        v = rope_chunk_v(v, pv, tc0[k], tc1[k], ts0[k], ts1[k], c < 2);
                        *(u32x4*)(p.krope + tok * 32 + c * 8) = v;
                    } else if (isq) {
                        *(u32x4*)(p.cq + tok * 384 + (col - 288)) = v;
                        float f[8]; unpack8(v, f);
#pragma unroll
                        for (int j = 0; j < 8; ++j) ss += f[j] * f[j];
                    } else {
                        *(u32x4*)(p.zb + tok * DM + (col - 672)) = v;
                    }
                    ss += __shfl_xor(ss, 1); ss += __shfl_xor(ss, 2); ss += __shfl_xor(ss, 4); ss += __shfl_xor(ss, 8); ss += __shfl_xor(ss, 16);
                    if (c == 0) atomicAdd(p.ssq + tok, ss);
                }
            }
        } else if (col < 1696) {
            bf16_t* dst = p.zb + (col - 672);
#pragma unroll
            for (int i = 0; i < 16; ++i) {
                const int rr = (t2 >> 5) + 16 * i;
                *(u32x4*)(dst + (long)(mt * 256 + rr) * DM) = *(const u32x4*)(smem + rr * CS + c * 16);
            }
        }
        __syncthreads();
    }
}

DI void phase_gemm_up(const Params& p, char* smem) {
    const int MT = p.CB * 8;
    const long total = (long)MT * 14;
    const int t = tid(), lane = t & 63, wid = t >> 6, wr = wid >> 2, wc = wid & 3;
    int R0, C0; stage_rc(t * 16, R0, C0);
    for (long L = bidx(); L < total; L += gridDim.x) {
        int mt, nt; if (!narrow_map(L, 14, MT, mt, nt)) continue;
        const int bl = mt >> 3, tt0 = (mt & 7) << 8;
        f32x4 acc[2][2][4][2];
        {
            const bool kv = nt < 8;
            const int Kd = kv ? 256 : 384;
            const bf16_t* a0 = (kv ? p.ckvn : p.cq) + (long)(mt * 256 + R0) * Kd + C0;
            const bf16_t* b0 = (kv ? p.WkvuT + (long)(nt * 256 + R0) * 256 : p.WquT + (long)((nt - 8) * 256 + R0) * 384) + C0;
            gemm_mainloop(a0, 64 * Kd, 128 * Kd, 192 * Kd, b0, Kd, Kd, smem, acc);
        }
        if (nt < 8) {
            if (wc < 2) stage_rm(acc, smem, CSH, 64, wc * 32, lane, wr, 1.0f);
            else stage_tr(acc, smem + 256 * CSH, 64, (wc - 2) * 32, lane, wr);
            __syncthreads();
            const int t2 = tid();
            {
                const int c = t2 & 15, head = 2 * nt + (c >> 3), cc = c & 7;
                bf16_t* dst = p.Kb + ((long)(bl * 16 + head) * 2048 + tt0) * 64 + cc * 8;
#pragma unroll
                for (int i = 0; i < 8; ++i) { const int rr = (t2 >> 4) + 32 * i; *(u32x4*)(dst + (long)rr * 64) = *(const u32x4*)(smem + rr * CSH + c * 16); }
            }
            {
                const int c = t2 & 31;
#pragma unroll
                for (int i = 0; i < 8; ++i) {
                    const int n = (t2 >> 5) + 16 * i, head = 2 * nt + (n >> 6), d = n & 63;
                    *(u32x4*)(p.VbT + ((long)(bl * 16 + head) * 64 + d) * 2048 + tt0 + c * 8) = *(const u32x4*)(smem + 256 * CSH + n * CS + c * 16);
                }
            }
        } else {
            const int n2 = nt - 8;
            stage_rm(acc, smem, CS, 128, wc * 32, lane, wr, 1.0f);
            __syncthreads();
            const int t2 = tid();
            const int c = t2 & 31;
            const int col = n2 * 256 + c * 8, head = col / 96, d = col - head * 96;
            bf16_t* dst = p.Qb + ((long)(bl * 16 + head) * 2048 + tt0) * 96 + d;
            float rsv[16];
#pragma unroll
            for (int i = 0; i < 16; ++i) rsv[i] = p.ssq[(long)mt * 256 + (t2 >> 5) + 16 * i];
#pragma unroll
            for (int i = 0; i < 16; ++i) rsv[i] = rsqrtf(rsv[i] * (1.0f / 384.0f) + EPS) * QSCALE_B;
            const bool isrot = d >= 64, lo = d < 80;
            const int pc = isrot ? (lo ? c + 2 : c - 2) : c;
#pragma unroll
            for (int hf = 0; hf < 4; ++hf) {
                f32x4 tc0[4], tc1[4], ts0[4], ts1[4];
#pragma unroll
                for (int k = 0; k < 4; ++k) {
                    const long tokc = (long)mt * 256 + (t2 >> 5) + 16 * (hf * 4 + k);
                    const float* cs = p.cosB + tokc * 16 + (d & 8); const float* sn = p.sinB + tokc * 16 + (d & 8);
                    tc0[k] = *(const f32x4*)cs; tc1[k] = *(const f32x4*)(cs + 4); ts0[k] = *(const f32x4*)sn; ts1[k] = *(const f32x4*)(sn + 4);
                }
#pragma unroll
                for (int k = 0; k < 4; ++k) {
                    const int i = hf * 4 + k;
                    const int rr = (t2 >> 5) + 16 * i;
                    u32x4 v = *(const u32x4*)(smem + rr * CS + c * 16);
                    const u32x4 pv = *(const u32x4*)(smem + rr * CS + pc * 16);
                    const u32x4 vr = rope_chunk_v(v, pv, tc0[k], tc1[k], ts0[k], ts1[k], lo);
                    v = isrot ? vr : v;
                    {
                        const float rs = rsv[i];
                        float f[8]; unpack8(v, f);
#pragma unroll
                        for (int j = 0; j < 8; ++j) f[j] *= rs;
                        v = pack8(f);
                    }
                    *(u32x4*)(dst + (long)rr * 96) = v;
                }
            }
        }
        __syncthreads();
    }
}

template <int DQK, int DV, bool ISA>
DI void attn_unit(const Params& p, char* smem, const bf16_t* __restrict__ Q, const bf16_t* __restrict__ K, const bf16_t* __restrict__ Kr, const bf16_t* __restrict__ Vt,
                  int q0, int kstart, int ntiles, int W, int segm, int e0, int e1, int e2, int e3) {
    constexpr int KS = DQK * 2 + 16, VS = 144;
    constexpr int KB = 64 * KS, VB = DV * VS, STAGE = KB + VB;
    constexpr int NS = DQK / 16, NDB = DV / 32;
    constexpr int KCH = DQK / 8, NKC = 64 * KCH, NKL = (NKC + NTHR - 1) / NTHR, NVL = DV * 8 / NTHR;
    static_assert(2 * STAGE <= SMEM_BYTES, "attention LDS");
    const int t = tid(), lane = t & 63, w = t >> 6, q = lane & 31, h = lane >> 5;
    bf16x8 qf[NS];
    {
        const bf16_t* qp = Q + (long)(w * 32 + q) * DQK + 8 * h;
#pragma unroll
        for (int s = 0; s < NS; ++s) qf[s] = *(const bf16x8*)(qp + 16 * s);
    }
    u32x4 rk[NKL], rv[NVL];
    auto gload = [&](int k0) {
#pragma unroll
        for (int i = 0; i < NKL; ++i) {
            const int idx = t + NTHR * i, kr = idx / KCH, c = idx - kr * KCH;
            if ((NKC % NTHR) == 0 || idx < NKC) rk[i] = ISA ? *(const u32x4*)(K + (long)(k0 + kr) * DQK + c * 8)
                                                          : (c < 8 ? *(const u32x4*)(K + (long)(k0 + kr) * 64 + c * 8) : *(const u32x4*)(Kr + (long)(k0 + kr) * 32 + (c - 8) * 8));
        }
#pragma unroll
        for (int i = 0; i < NVL; ++i) { const int idx = t + NTHR * i, d = idx >> 3, c = idx & 7; rv[i] = *(const u32x4*)(Vt + (long)d * 2048 + k0 + c * 8); }
    };
    auto lwrite = [&](char* st) {
#pragma unroll
        for (int i = 0; i < NKL; ++i) {
            const int idx = t + NTHR * i, kr = idx / KCH, c = idx - kr * KCH;
            if ((NKC % NTHR) == 0 || idx < NKC) *(u32x4*)(st + kr * KS + c * 16) = rk[i];
        }
#pragma unroll
        for (int i = 0; i < NVL; ++i) {
            const int idx = t + NTHR * i, d = idx >> 3, c = idx & 7;
            char* vp = st + KB + d * VS + ((c >> 1) * 16 + 4 * (c & 1)) * 2;
            u32x2 a = {rv[i].x, rv[i].y}, b = {rv[i].z, rv[i].w};
            *(u32x2*)vp = a; *(u32x2*)(vp + 16) = b;
        }
    };
    float m = -1e30f, l = 0.f;
    f32x16 o[NDB];
#pragma unroll
    for (int db = 0; db < NDB; ++db)
#pragma unroll
        for (int i = 0; i < 16; ++i) o[db][i] = 0.f;
    gload(kstart); lwrite(smem); __syncthreads();
    const int qw0 = q0 + w * 32;
    const int seg0 = qw0 & ~segm;
    const int klo = max(qw0 - W, seg0);
    for (int kt = 0; kt < ntiles; ++kt) {
        const char* st = smem + (kt & 1) * STAGE;
        const int k0 = kstart + kt * 64;
        if (kt + 1 < ntiles) gload(k0 + 64);
        __builtin_amdgcn_sched_barrier(0);
        const bool need = (k0 <= qw0 + 31) && (k0 + 63 >= klo);
        if (need) {
            f32x16 s0, s1;
#pragma unroll
            for (int i = 0; i < 16; ++i) { s0[i] = 0.f; s1[i] = 0.f; }
            const char* kp = st + q * KS + h * 16;
            {
                bf16x8 kfa[NS], kfb[NS];
#pragma unroll
                for (int s = 0; s < NS; ++s) kfa[s] = *(const bf16x8*)(kp + s * 32);
#pragma unroll
                for (int s = 0; s < NS; ++s) kfb[s] = *(const bf16x8*)(kp + 32 * KS + s * 32);
                __builtin_amdgcn_sched_barrier(0);
#pragma unroll
                for (int s = 0; s < NS; ++s) s0 = MFMA(kfa[s], qf[s], s0);
#pragma unroll
                for (int s = 0; s < NS; ++s) s1 = MFMA(kfb[s], qf[s], s1);
            }
            const bool full = (k0 + 63 <= qw0) && (k0 >= max(qw0 + 31 - W, seg0));
            if (!full) {
                const int qpos = qw0 + q;
                const int lo = max(qpos - W, seg0);
#pragma unroll
                for (int i = 0; i < 16; ++i) {
                    const int key = k0 + (i & 3) + 8 * (i >> 2) + 4 * h;
                    const bool ok0 = (key <= qpos) && (key >= lo);
                    const bool ok1 = (key + 32 <= qpos) && (key + 32 >= lo);
                    s0[i] = ok0 ? s0[i] : -INFINITY; s1[i] = ok1 ? s1[i] : -INFINITY;
                }
            }
            float mx = fmaxf(s0[0], s1[0]);
#pragma unroll
            for (int i = 1; i < 16; ++i) mx = fmaxf(mx, fmaxf(s0[i], s1[i]));
            mx = fmaxf(mx, __shfl_xor(mx, 32));
            const float mn = fmaxf(m, mx), alpha = fexp2(m - mn);
            m = mn;
            float ps = 0.f;
#pragma unroll
            for (int i = 0; i < 16; ++i) { s0[i] = fexp2(s0[i] - mn); s1[i] = fexp2(s1[i] - mn); ps += s0[i] + s1[i]; }
            l = l * alpha + ps;
#pragma unroll
            for (int db = 0; db < NDB; ++db)
#pragma unroll
                for (int i = 0; i < 16; ++i) o[db][i] *= alpha;
            const char* vp = st + KB + q * VS + h * 16;
            u32x4 pp[4];
            pp[0].x = pk2(s0[0], s0[1]);  pp[0].y = pk2(s0[2], s0[3]);   pp[0].z = pk2(s0[4], s0[5]);   pp[0].w = pk2(s0[6], s0[7]);
            pp[1].x = pk2(s0[8], s0[9]);  pp[1].y = pk2(s0[10], s0[11]); pp[1].z = pk2(s0[12], s0[13]); pp[1].w = pk2(s0[14], s0[15]);
            pp[2].x = pk2(s1[0], s1[1]);  pp[2].y = pk2(s1[2], s1[3]);   pp[2].z = pk2(s1[4], s1[5]);   pp[2].w = pk2(s1[6], s1[7]);
            pp[3].x = pk2(s1[8], s1[9]);  pp[3].y = pk2(s1[10], s1[11]); pp[3].z = pk2(s1[12], s1[13]); pp[3].w = pk2(s1[14], s1[15]);
#pragma unroll
            for (int gp = 0; gp < 2; ++gp) {
                bf16x8 vf[2][NDB];
#pragma unroll
                for (int gg = 0; gg < 2; ++gg)
#pragma unroll
                    for (int db = 0; db < NDB; ++db) vf[gg][db] = *(const bf16x8*)(vp + db * 32 * VS + (gp * 2 + gg) * 32);
                __builtin_amdgcn_sched_barrier(0);
#pragma unroll
                for (int gg = 0; gg < 2; ++gg)
#pragma unroll
                    for (int db = 0; db < NDB; ++db) o[db] = MFMA(vf[gg][db], __builtin_bit_cast(bf16x8, pp[gp * 2 + gg]), o[db]);
            }
        }
        if (kt + 1 < ntiles) lwrite(smem + ((kt + 1) & 1) * STAGE);
        __syncthreads();
    }
    const float lt = l + __shfl_xor(l, 32);
    const float inv = 1.0f / lt;
    const int qi = w * 32 + q;
    if (ISA) {
        const int NT = p.CB * 2048;
        const int pp = q0 + qi, dsh = e3, Lsh = 11 - dsh, Lm = (2048 >> dsh) - 1;
        const int tt = ((pp & Lm) << dsh) + (pp >> Lsh);
        const long tok = (long)e1 * 2048 + tt;
        bf16_t* dst = p.Oa + ((long)e0 * NT + tok) * DM + e2 * 128 + 4 * h;
#pragma unroll
        for (int db = 0; db < NDB; ++db)
#pragma unroll
            for (int g = 0; g < 4; ++g) {
                u32x2 v; v.x = pk2(o[db][4 * g] * inv, o[db][4 * g + 1] * inv); v.y = pk2(o[db][4 * g + 2] * inv, o[db][4 * g + 3] * inv);
                *(u32x2*)(dst + db * 32 + g * 8) = v;
            }
        if (h == 0) p.La[((long)e0 * NT + tok) * 8 + e2] = m + __log2f(lt);
    } else {
        constexpr int OS = DV * 2 + 16;
        char* orow = smem + qi * OS + 8 * h;
#pragma unroll
        for (int db = 0; db < NDB; ++db)
#pragma unroll
            for (int g = 0; g < 4; ++g) {
                u32x2 v; v.x = pk2(o[db][4 * g] * inv, o[db][4 * g + 1] * inv); v.y = pk2(o[db][4 * g + 2] * inv, o[db][4 * g + 3] * inv);
                *(u32x2*)(orow + (db * 32 + g * 8) * 2) = v;
            }
        __syncthreads();
        constexpr int CPR = DV / 8;
        const int t2 = tid(), c = t2 % CPR;
        const long tok0 = (long)e1 * 2048 + q0;
#pragma unroll
        for (int i = 0; i < (256 * CPR) / NTHR; ++i) {
            const int rr = t2 / CPR + (NTHR / CPR) * i;
            float ov[8], zv[8], y[8];
            unpack8(*(const u32x4*)(smem + rr * OS + c * 16), ov);
            unpack8(*(const u32x4*)(p.zb + (tok0 + rr) * DM + e2 * DV + c * 8), zv);
#pragma unroll
            for (int j = 0; j < 8; ++j) y[j] = ov[j] * silu(zv[j]);
            *(u32x4*)(p.y2 + (tok0 + rr) * DM + e2 * DV + c * 8) = pack8(y);
        }
        __syncthreads();
    }
}

DI void attn_unit_a(const Params& p, char* smem, const bf16_t* __restrict__ Q, const bf16_t* __restrict__ K, const bf16_t* __restrict__ Vt,
                    int q0, int kstart, int ntiles, int segm, int e0, int e1, int e2, int e3) {
    constexpr int DQK = 128, DV = 128, W = 128;
    constexpr bool ISA = true;
    constexpr int KS = DQK * 2 + 16, VS = 144;
    constexpr int KB = 64 * KS, VB = DV * VS, STAGE = KB + VB;
    constexpr int NS = DQK / 16, NDB = DV / 32;
    constexpr int KCH = DQK / 8;
    static_assert(4 * STAGE <= SMEM_BYTES, "attention-A LDS");
    const int t = tid(), lane = t & 63, w = t >> 6, q = lane & 31, h = lane >> 5;
    bf16x8 qf[NS];
    {
        const bf16_t* qp = Q + (long)(w * 32 + q) * DQK + 8 * h;
#pragma unroll
        for (int s = 0; s < NS; ++s) qf[s] = *(const bf16x8*)(qp + 16 * s);
    }
    const int kr0 = t >> 4, kc = t & 15, vd0 = t >> 3, vc = t & 7;
    const bf16_t* kg = K + (long)(kstart + kr0) * DQK + kc * 8;
    const bf16_t* vg = Vt + (long)vd0 * 2048 + kstart + vc * 8;
    const int kwo = kr0 * KS + kc * 16, vwo = KB + vd0 * VS + ((vc >> 1) * 16 + 4 * (vc & 1)) * 2;
    auto gload = [&](int tile, u32x4 (&r)[4]) {
        r[0] = *(const u32x4*)(kg + (long)(tile * 64) * DQK); r[1] = *(const u32x4*)(kg + (long)(tile * 64 + 32) * DQK);
        r[2] = *(const u32x4*)(vg + tile * 64);               r[3] = *(const u32x4*)(vg + 64 * 2048 + tile * 64);
    };
    auto lwrite = [&](char* st, const u32x4 (&r)[4]) {
        *(u32x4*)(st + kwo) = r[0]; *(u32x4*)(st + kwo + 32 * KS) = r[1];
        { u32x2 a = {r[2].x, r[2].y}, b = {r[2].z, r[2].w}; *(u32x2*)(st + vwo) = a; *(u32x2*)(st + vwo + 16) = b; }
        { u32x2 a = {r[3].x, r[3].y}, b = {r[3].z, r[3].w}; *(u32x2*)(st + vwo + 64 * VS) = a; *(u32x2*)(st + vwo + 64 * VS + 16) = b; }
    };
    {
        u32x4 r0[4], r1[4], r2[4], r3[4];
        gload(0, r0); gload(1, r1); gload(2, r2); gload(3, r3);
        lwrite(smem, r0); lwrite(smem + STAGE, r1); lwrite(smem + 2 * STAGE, r2); lwrite(smem + 3 * STAGE, r3);
    }
    float m = -1e30f, l = 0.f;
    f32x16 o[NDB];
#pragma unroll
    for (int db = 0; db < NDB; ++db)
#pragma unroll
        for (int i = 0; i < 16; ++i) o[db][i] = 0.f;
    __syncthreads();
    const int qw0 = q0 + w * 32;
    const int seg0 = qw0 & ~segm;
    const int klo = max(qw0 - W, seg0);
    const int off = (q0 - kstart) >> 6;
    u32x4 rn[4];
    for (int it = 0; it < 3; ++it) {
        if (it + 4 < ntiles) gload(it + 4, rn);
        __builtin_amdgcn_sched_barrier(0);
        const int tile = (w >> 1) + off - 2 + it;
        const int k0 = kstart + tile * 64;
        const char* st = smem + (tile & 3) * STAGE;
        const bool need = (tile >= 0) && (tile < ntiles) && (k0 <= qw0 + 31) && (k0 + 63 >= klo);
        if (need) {
            f32x16 s0, s1;
#pragma unroll
            for (int i = 0; i < 16; ++i) { s0[i] = 0.f; s1[i] = 0.f; }
            const char* kp = st + q * KS + h * 16;
            {
                bf16x8 kfa[NS], kfb[NS];
#pragma unroll
                for (int s = 0; s < NS; ++s) kfa[s] = *(const bf16x8*)(kp + s * 32);
#pragma unroll
                for (int s = 0; s < NS; ++s) kfb[s] = *(const bf16x8*)(kp + 32 * KS + s * 32);
                __builtin_amdgcn_sched_barrier(0);
#pragma unroll
                for (int s = 0; s < NS; ++s) s0 = MFMA(kfa[s], qf[s], s0);
#pragma unroll
                for (int s = 0; s < NS; ++s) s1 = MFMA(kfb[s], qf[s], s1);
            }
            const bool full = (k0 + 63 <= qw0) && (k0 >= max(qw0 + 31 - W, seg0));
            if (!full) {
                const int qpos = qw0 + q;
                const int lo = max(qpos - W, seg0);
#pragma unroll
                for (int i = 0; i < 16; ++i) {
                    const int key = k0 + (i & 3) + 8 * (i >> 2) + 4 * h;
                    const bool ok0 = (key <= qpos) && (key >= lo);
                    const bool ok1 = (key + 32 <= qpos) && (key + 32 >= lo);
                    s0[i] = ok0 ? s0[i] : -INFINITY; s1[i] = ok1 ? s1[i] : -INFINITY;
                }
            }
            float mx = fmaxf(s0[0], s1[0]);
#pragma unroll
            for (int i = 1; i < 16; ++i) mx = fmaxf(mx, fmaxf(s0[i], s1[i]));
            mx = fmaxf(mx, __shfl_xor(mx, 32));
            const float mn = fmaxf(m, mx), alpha = fexp2(m - mn);
            m = mn;
            float ps = 0.f;
#pragma unroll
            for (int i = 0; i < 16; ++i) { s0[i] = fexp2(s0[i] - mn); s1[i] = fexp2(s1[i] - mn); ps += s0[i] + s1[i]; }
            l = l * alpha + ps;
#pragma unroll
            for (int db = 0; db < NDB; ++db)
#pragma unroll
                for (int i = 0; i < 16; ++i) o[db][i] *= alpha;
            const char* vp = st + KB + q * VS + h * 16;
            u32x4 pp[4];
            pp[0].x = pk2(s0[0], s0[1]);  pp[0].y = pk2(s0[2], s0[3]);   pp[0].z = pk2(s0[4], s0[5]);   pp[0].w = pk2(s0[6], s0[7]);
            pp[1].x = pk2(s0[8], s0[9]);  pp[1].y = pk2(s0[10], s0[11]); pp[1].z = pk2(s0[12], s0[13]); pp[1].w = pk2(s0[14], s0[15]);
            pp[2].x = pk2(s1[0], s1[1]);  pp[2].y = pk2(s1[2], s1[3]);   pp[2].z = pk2(s1[4], s1[5]);   pp[2].w = pk2(s1[6], s1[7]);
            pp[3].x = pk2(s1[8], s1[9]);  pp[3].y = pk2(s1[10], s1[11]); pp[3].z = pk2(s1[12], s1[13]); pp[3].w = pk2(s1[14], s1[15]);
#pragma unroll
            for (int gp = 0; gp < 2; ++gp) {
                bf16x8 vf[2][NDB];
#pragma unroll
                for (int gg = 0; gg < 2; ++gg)
#pragma unroll
                    for (int db = 0; db < NDB; ++db) vf[gg][db] = *(const bf16x8*)(vp + db * 32 * VS + (gp * 2 + gg) * 32);
                __builtin_amdgcn_sched_barrier(0);
#pragma unroll
                for (int gg = 0; gg < 2; ++gg)
#pragma unroll
                    for (int db = 0; db < NDB; ++db) o[db] = MFMA(vf[gg][db], __builtin_bit_cast(bf16x8, pp[gp * 2 + gg]), o[db]);
            }
        }
        if (it + 4 < ntiles) {
            __syncthreads();
            lwrite(smem + (it & 3) * STAGE, rn);
        }
        __syncthreads();
    }
    const float lt = l + __shfl_xor(l, 32);
    const float inv = 1.0f / lt;
    const int qi = w * 32 + q;
    {
        const int NT = p.CB * 2048;
        const int dsh = e3, Lsh = 11 - dsh, Lm = (2048 >> dsh) - 1;
        char* orow = smem + qi * 272 + 8 * h;
#pragma unroll
        for (int db = 0; db < NDB; ++db)
#pragma unroll
            for (int g = 0; g < 4; ++g) {
                u32x2 v; v.x = pk2(o[db][4 * g] * inv, o[db][4 * g + 1] * inv); v.y = pk2(o[db][4 * g + 2] * inv, o[db][4 * g + 3] * inv);
                *(u32x2*)(orow + (db * 32 + g * 8) * 2) = v;
            }
        if (h == 0) {
            const int pp = q0 + qi, tt = ((pp & Lm) << dsh) + (pp >> Lsh);
            p.La[((long)e0 * NT + (long)e1 * 2048 + tt) * 8 + e2] = m + __log2f(lt);
        }
        __syncthreads();
        const int t2 = tid(), c = t2 & 15;
        bf16_t* dst = p.Oa + ((long)e0 * NT + (long)e1 * 2048) * DM + e2 * 128 + c * 8;
#pragma unroll
        for (int i = 0; i < 8; ++i) {
            const int rr = (t2 >> 4) + 32 * i, pp = q0 + rr, tt = ((pp & Lm) << dsh) + (pp >> Lsh);
            *(u32x4*)(dst + (long)tt * DM) = *(const u32x4*)(smem + rr * 272 + c * 16);
        }
        __syncthreads();
    }
}

DI void phase_attn_a(const Params& p, char* smem) {
    const int NBL = p.CB, bl0 = 0;
    const int CB = p.CB;
    const long total = (long)3 * NBL * 8 * 8;
    for (long L = bidx(); L < total; L += gridDim.x) {
        const long it = L >> 8; const int v0 = (int)(L & 255);
        const int v = (v0 & 7) * 32 + (v0 >> 3);
        const long u = it * 256 + v;
        if (u >= total) continue;
        const int blk = (int)(u & 7); const long hbs = u >> 3;
        const int head = (int)(hbs & 7); const int gb = (int)(hbs >> 3); const int g = gb / NBL, bl = bl0 + (gb - g * NBL);
        const long hb = (long)(g * CB + bl) * 8 + head;
        const int dsh = 2 * g, Lm = (2048 >> dsh) - 1;
        const int pp0 = blk * 256;
        const int segs = pp0 & ~Lm;
        const int kstart = max(pp0 - 128, segs);
        const int nt = (pp0 + 256 - kstart) >> 6;
        attn_unit_a(p, smem, p.Qa + (hb * 2048 + pp0) * 128, p.Ka + hb * 2048 * 128, p.VaT + hb * 128 * 2048,
                    pp0, kstart, nt, Lm, g, bl, head, dsh);
    }
}

DI void attn_unit_b(const Params& p, char* smem, const bf16_t* __restrict__ Q, const bf16_t* __restrict__ K, const bf16_t* __restrict__ Kr, const bf16_t* __restrict__ Vt,
                    int q0, int ntiles  , int e1, int e2) {
    constexpr int DQK = 96, DV = 64, TK = 128;
    constexpr int KS = DQK * 2 + 16, VS = TK * 2 + 16;
    constexpr int KB = TK * KS, VB = DV * VS, STAGE = KB + VB;
    constexpr int NS = DQK / 16, NDB = DV / 32;
    static_assert(2 * STAGE <= SMEM_BYTES, "attention-B LDS");
    const int t = tid(), lane = t & 63, w = t >> 6, q = lane & 31, h = lane >> 5;
    bf16x8 qf[NS];
    {
        const bf16_t* qp = Q + (long)(w * 32 + q) * DQK + 8 * h;
#pragma unroll
        for (int s = 0; s < NS; ++s) qf[s] = *(const bf16x8*)(qp + 16 * s);
    }
    u32x4 rk[3], rv[2];
    auto gload = [&](int k0) {
#pragma unroll
        for (int i = 0; i < 3; ++i) {
            const int idx = t + NTHR * i, kr = idx / 12, c = idx - kr * 12;
            rk[i] = c < 8 ? *(const u32x4*)(K + (long)(k0 + kr) * 64 + c * 8) : *(const u32x4*)(Kr + (long)(k0 + kr) * 32 + (c - 8) * 8);
        }
#pragma unroll
        for (int i = 0; i < 2; ++i) { const int idx = t + NTHR * i, d = idx >> 4, c = idx & 15; rv[i] = *(const u32x4*)(Vt + (long)d * 2048 + k0 + c * 8); }
    };
    auto lwrite = [&](char* st) {
#pragma unroll
        for (int i = 0; i < 3; ++i) { const int idx = t + NTHR * i, kr = idx / 12, c = idx - kr * 12; *(u32x4*)(st + kr * KS + c * 16) = rk[i]; }
#pragma unroll
        for (int i = 0; i < 2; ++i) {
            const int idx = t + NTHR * i, d = idx >> 4, c = idx & 15;
            char* vp = st + KB + d * VS + ((c >> 1) * 16 + 4 * (c & 1)) * 2;
            u32x2 a = {rv[i].x, rv[i].y}, b = {rv[i].z, rv[i].w};
            *(u32x2*)vp = a; *(u32x2*)(vp + 16) = b;
        }
    };
    float m = -1e30f, l = 0.f;
    f32x16 o[NDB];
#pragma unroll
    for (int db = 0; db < NDB; ++db)
#pragma unroll
        for (int i = 0; i < 16; ++i) o[db][i] = 0.f;
    gload(0); lwrite(smem); __syncthreads();
    const int qw0 = q0 + w * 32;
    for (int kt = 0; kt < ntiles; ++kt) {
        const char* st = smem + (kt & 1) * STAGE;
        const int k0 = kt * TK;
        if (kt + 1 < ntiles) gload(k0 + TK);
        __builtin_amdgcn_sched_barrier(0);
        if (k0 <= qw0 + 31) {
            f32x16 sc[4];
#pragma unroll
            for (int kb = 0; kb < 4; ++kb)
#pragma unroll
                for (int i = 0; i < 16; ++i) sc[kb][i] = 0.f;
            const char* kp = st + q * KS + h * 16;
#pragma unroll
            for (int kb = 0; kb < 4; ++kb) {
                if (k0 + kb * 32 <= qw0 + 31) {
                    bf16x8 kf[NS];
#pragma unroll
                    for (int s = 0; s < NS; ++s) kf[s] = *(const bf16x8*)(kp + kb * 32 * KS + s * 32);
#pragma unroll
                    for (int s = 0; s < NS; ++s) sc[kb] = MFMA(kf[s], qf[s], sc[kb]);
                }
            }
            if (k0 + TK - 1 > qw0) {
                const int qpos = qw0 + q;
#pragma unroll
                for (int kb = 0; kb < 4; ++kb)
#pragma unroll
                    for (int i = 0; i < 16; ++i) {
                        const int key = k0 + kb * 32 + (i & 3) + 8 * (i >> 2) + 4 * h;
                        sc[kb][i] = (key <= qpos) ? sc[kb][i] : -INFINITY;
                    }
            }
            float mx = fmaxf(fmaxf(sc[0][0], sc[1][0]), fmaxf(sc[2][0], sc[3][0]));
#pragma unroll
            for (int i = 1; i < 16; ++i) mx = fmaxf(mx, fmaxf(fmaxf(sc[0][i], sc[1][i]), fmaxf(sc[2][i], sc[3][i])));
            mx = fmaxf(mx, __shfl_xor(mx, 32));
            const float mn = fmaxf(m, mx), alpha = fexp2(m - mn);
            m = mn;
            float ps = 0.f;
#pragma unroll
            for (int kb = 0; kb < 4; ++kb)
#pragma unroll
                for (int i = 0; i < 16; ++i) { sc[kb][i] = fexp2(sc[kb][i] - mn); ps += sc[kb][i]; }
            l = l * alpha + ps;
#pragma unroll
            for (int db = 0; db < NDB; ++db)
#pragma unroll
                for (int i = 0; i < 16; ++i) o[db][i] *= alpha;
            const char* vp = st + KB + q * VS + h * 16;
#pragma unroll
            for (int kb = 0; kb < 4; ++kb) {
                if (k0 + kb * 32 <= qw0 + 31) {
                    u32x4 pa, pb;
                    pa.x = pk2(sc[kb][0], sc[kb][1]);  pa.y = pk2(sc[kb][2], sc[kb][3]);   pa.z = pk2(sc[kb][4], sc[kb][5]);   pa.w = pk2(sc[kb][6], sc[kb][7]);
                    pb.x = pk2(sc[kb][8], sc[kb][9]);  pb.y = pk2(sc[kb][10], sc[kb][11]); pb.z = pk2(sc[kb][12], sc[kb][13]); pb.w = pk2(sc[kb][14], sc[kb][15]);
                    bf16x8 vf[2][NDB];
#pragma unroll
                    for (int gg = 0; gg < 2; ++gg)
#pragma unroll
                        for (int db = 0; db < NDB; ++db) vf[gg][db] = *(const bf16x8*)(vp + db * 32 * VS + (kb * 2 + gg) * 32);
#pragma unroll
                    for (int db = 0; db < NDB; ++db) { o[db] = MFMA(vf[0][db], __builtin_bit_cast(bf16x8, pa), o[db]); o[db] = MFMA(vf[1][db], __builtin_bit_cast(bf16x8, pb), o[db]); }
                }
            }
        }
        if (kt + 1 < ntiles) lwrite(smem + ((kt + 1) & 1) * STAGE);
        __syncthreads();
    }
    const float lt = l + __shfl_xor(l, 32);
    const float inv = 1.0f / lt;
    const int qi = w * 32 + q;
    {
        constexpr int OS = DV * 2 + 16;
        char* orow = smem + qi * OS + 8 * h;
#pragma unroll
        for (int db = 0; db < NDB; ++db)
#pragma unroll
            for (int g = 0; g < 4; ++g) {
                u32x2 v; v.x = pk2(o[db][4 * g] * inv, o[db][4 * g + 1] * inv); v.y = pk2(o[db][4 * g + 2] * inv, o[db][4 * g + 3] * inv);
                *(u32x2*)(orow + (db * 32 + g * 8) * 2) = v;
            }
        __syncthreads();
        const int t2 = tid(), c = t2 & 7;
        const long tok0 = (long)e1 * 2048 + q0;
#pragma unroll
        for (int i = 0; i < 4; ++i) {
            const int rr = (t2 >> 3) + 64 * i;
            float ov[8], zv[8], y[8];
            unpack8(*(const u32x4*)(smem + rr * OS + c * 16), ov);
            unpack8(*(const u32x4*)(p.zb + (tok0 + rr) * DM + e2 * DV + c * 8), zv);
#pragma unroll
            for (int j = 0; j < 8; ++j) y[j] = ov[j] * silu(zv[j]);
            *(u32x4*)(p.y2 + (tok0 + rr) * DM + e2 * DV + c * 8) = pack8(y);
        }
        __syncthreads();
    }
}

DI void phase_attn_b(const Params& p, char* smem) {
    const int CB = p.CB;
    const long nbh = (long)CB * 16, total = nbh * 8;
    for (long L = bidx(); L < total; L += gridDim.x) {
        const long bh = L % nbh; const int qb = 7 - (int)(L / nbh);
        const int bl = (int)(bh >> 4), head = (int)(bh & 15);
        attn_unit_b(p, smem, p.Qb + (bh * 2048 + qb * 256) * 96, p.Kb + bh * 2048 * 64, p.krope + (long)bl * 2048 * 32, p.VbT + bh * 64 * 2048, qb * 256, 2 * (qb + 1), bl, head);
    }
}

DI void phase_pre(const Params& p, int b0) {
    const int NT = p.CB * 2048;
    const long gt = (long)bidx() * NTHR + tid(), nth = (long)gridDim.x * NTHR;
    for (long idx = gt; idx < (long)NT * 16; idx += nth) {
        const int tokc = (int)(idx >> 4), f = (int)(idx & 15);
        const float ps = (float)p.pos[(long)b0 * 2048 + tokc];
        const float e = (float)f * 0.0625f;
        const float ia = 1.0f / powf(500000.0f, e), ib = 1.0f / powf(10000.0f, e);
        const float aa = ps * ia, ab = ps * ib;
        p.cosA[idx] = cosf(aa); p.sinA[idx] = sinf(aa); p.cosB[idx] = cosf(ab); p.sinB[idx] = sinf(ab);
    }
    const int lane = tid() & 63;
    const int gw = bidx() * 8 + (tid() >> 6), nw = gridDim.x * 8;
    for (int row = gw; row < NT; row += nw) {
        const float* xp = p.x + ((long)b0 * 2048 + row) * DM + lane * 4;
        f32x4 v[4]; float ss = 0.f;
#pragma unroll
        for (int i = 0; i < 4; ++i) { v[i] = *(const f32x4*)(xp + i * 256); ss += v[i].x * v[i].x + v[i].y * v[i].y + v[i].z * v[i].z + v[i].w * v[i].w; }
        ss = wave_sum(ss);
        const float rstd = rsqrtf(ss * (1.0f / 1024.0f) + EPS);
#pragma unroll
        for (int i = 0; i < 4; ++i) {
            const f32x4 g = *(const f32x4*)(p.a_pre + i * 256 + lane * 4);
            u32x2 o; o.x = pk2(v[i].x * rstd * g.x, v[i].y * rstd * g.y); o.y = pk2(v[i].z * rstd * g.z, v[i].w * rstd * g.w);
            *(u32x2*)(p.hn0 + (long)row * DM + i * 256 + lane * 4) = o;
        }
    }
}

DI void phase_merge(const Params& p) {
    const int NT = p.CB * 2048;
    const long gt = (long)bidx() * NTHR + tid(), nth = (long)gridDim.x * NTHR;
    for (long idx = gt; idx < (long)NT * 128; idx += nth) {
        const long tok = idx >> 7; const int c = (int)(idx & 127), head = c >> 4;
        const float l0 = p.La[((long)0 * NT + tok) * 8 + head], l1 = p.La[((long)1 * NT + tok) * 8 + head], l2 = p.La[((long)2 * NT + tok) * 8 + head];
        const float mx = fmaxf(l0, fmaxf(l1, l2));
        float w0 = fexp2(l0 - mx), w1 = fexp2(l1 - mx), w2 = fexp2(l2 - mx);
        const float inv = 1.0f / (w0 + w1 + w2);
        w0 *= inv; w1 *= inv; w2 *= inv;
        float a[8], b[8], cc[8], z[8], y[8];
        unpack8(*(const u32x4*)(p.Oa + ((long)0 * NT + tok) * DM + c * 8), a);
        unpack8(*(const u32x4*)(p.Oa + ((long)1 * NT + tok) * DM + c * 8), b);
        unpack8(*(const u32x4*)(p.Oa + ((long)2 * NT + tok) * DM + c * 8), cc);
        unpack8(*(const u32x4*)(p.Za + tok * DM + c * 8), z);
#pragma unroll
        for (int j = 0; j < 8; ++j) y[j] = (w0 * a[j] + w1 * b[j] + w2 * cc[j]) * silu(z[j]);
        *(u32x4*)(p.hn0 + tok * DM + c * 8) = pack8(y);
    }
}

DI void phase_post_a(const Params& p, int b0) {
    const int NT = p.CB * 2048;
    const int lane = tid() & 63;
    const int gw = bidx() * 8 + (tid() >> 6), nw = gridDim.x * 8;
    for (int row = gw; row < NT; row += nw) {
        const long grow = (long)b0 * 2048 + row;
        float y[16]; float ss = 0.f;
#pragma unroll
        for (int i = 0; i < 2; ++i) {
            float f[8]; unpack8(*(const u32x4*)(p.Za + (long)row * DM + i * 512 + lane * 8), f);
#pragma unroll
            for (int j = 0; j < 8; ++j) { y[8 * i + j] = f[j]; ss += f[j] * f[j]; }
        }
        ss = wave_sum(ss);
        const float rstd = rsqrtf(ss * (1.0f / 1024.0f) + EPS);
        float hv[16]; float s2 = 0.f;
#pragma unroll
        for (int i = 0; i < 2; ++i)
#pragma unroll
            for (int k = 0; k < 2; ++k) {
                const int col = i * 512 + lane * 8 + 4 * k;
                const f32x4 xx = *(const f32x4*)(p.x + grow * DM + col), gg = *(const f32x4*)(p.a_post + col);
                f32x4 hh;
                hh.x = xx.x + y[8 * i + 4 * k] * rstd * gg.x; hh.y = xx.y + y[8 * i + 4 * k + 1] * rstd * gg.y;
                hh.z = xx.z + y[8 * i + 4 * k + 2] * rstd * gg.z; hh.w = xx.w + y[8 * i + 4 * k + 3] * rstd * gg.w;
                hv[8 * i + 4 * k] = hh.x; hv[8 * i + 4 * k + 1] = hh.y; hv[8 * i + 4 * k + 2] = hh.z; hv[8 * i + 4 * k + 3] = hh.w;
                s2 += hh.x * hh.x + hh.y * hh.y + hh.z * hh.z + hh.w * hh.w;
            }
        s2 = wave_sum(s2);
        if (lane == 0) p.ssq[row] = 0.f;
        const float r2 = rsqrtf(s2 * (1.0f / 1024.0f) + EPS);
#pragma unroll
        for (int i = 0; i < 2; ++i) {
            float a[8];
#pragma unroll
            for (int j = 0; j < 8; ++j) a[j] = hv[8 * i + j] * r2;
            *(u32x4*)(p.hn1 + (long)row * DM + i * 512 + lane * 8) = pack8(a);
        }
    }
}

DI void phase_latent(const Params& p) {
    const int NT = p.CB * 2048;
    const int lane = tid() & 63;
    const int gw = bidx() * 8 + (tid() >> 6), nw = gridDim.x * 8;
    for (int row = gw; row < NT; row += nw) {
        const bf16_t* cr = p.ckr + (long)row * 288;
        {
            const u32x2 v = *(const u32x2*)(cr + lane * 4);
            const float f0 = bflo(v.x), f1 = bfhi(v.x), f2 = bflo(v.y), f3 = bfhi(v.y);
            float ss = wave_sum(f0 * f0 + f1 * f1 + f2 * f2 + f3 * f3);
            const float rstd = rsqrtf(ss * (1.0f / 256.0f) + EPS);
            const f32x4 g = *(const f32x4*)(p.kv_lat + lane * 4);
            u32x2 o; o.x = pk2(f0 * rstd * g.x, f1 * rstd * g.y); o.y = pk2(f2 * rstd * g.z, f3 * rstd * g.w);
            *(u32x2*)(p.ckvn + (long)row * 256 + lane * 4) = o;
        }
        {
            const int head = lane >> 2, part = lane & 3;
            const bool lo = part < 2;
            const u32x4 own = *(const u32x4*)(cr + 256 + part * 8), par = *(const u32x4*)(cr + 256 + (part ^ 2) * 8);
            const u32x4 v = rope_chunk(own, par, p.cosB + (long)row * 16 + (part & 1) * 8, p.sinB + (long)row * 16 + (part & 1) * 8, lo);
            const int bl = row >> 11, tt = row & 2047;
            *(u32x4*)(p.Kb + ((long)(bl * 16 + head) * 2048 + tt) * 96 + 64 + part * 8) = v;
        }
        {
            float f[8]; float ss = 0.f;
            if (lane < 48) {
                unpack8(*(const u32x4*)(p.cq + (long)row * 384 + lane * 8), f);
#pragma unroll
                for (int j = 0; j < 8; ++j) ss += f[j] * f[j];
            } else {
#pragma unroll
                for (int j = 0; j < 8; ++j) f[j] = 0.f;
            }
            ss = wave_sum(ss);
            const float rstd = rsqrtf(ss * (1.0f / 384.0f) + EPS);
            if (lane < 48) {
                const f32x4 g0 = *(const f32x4*)(p.b_qn + lane * 8), g1 = *(const f32x4*)(p.b_qn + lane * 8 + 4);
                float o[8] = {f[0] * rstd * g0.x, f[1] * rstd * g0.y, f[2] * rstd * g0.z, f[3] * rstd * g0.w, f[4] * rstd * g1.x, f[5] * rstd * g1.y, f[6] * rstd * g1.z, f[7] * rstd * g1.w};
                *(u32x4*)(p.cqn + (long)row * 384 + lane * 8) = pack8(o);
            }
        }
    }
}

DI void phase_final(const Params& p, int b0) {
    const int NT = p.CB * 2048;
    const int lane = tid() & 63;
    const int gw = bidx() * 8 + (tid() >> 6), nw = gridDim.x * 8;
    for (int row = gw; row < NT; row += nw) {
        const long grow = (long)b0 * 2048 + row;
        float ya[16], yb[16]; float sa = 0.f, sb = 0.f;
#pragma unroll
        for (int i = 0; i < 2; ++i) {
            float f[8], g[8];
            unpack8(*(const u32x4*)(p.Za + (long)row * DM + i * 512 + lane * 8), f);
            unpack8(*(const u32x4*)(p.yB + (long)row * DM + i * 512 + lane * 8), g);
#pragma unroll
            for (int j = 0; j < 8; ++j) { ya[8 * i + j] = f[j]; sa += f[j] * f[j]; yb[8 * i + j] = g[j]; sb += g[j] * g[j]; }
        }
        sa = wave_sum(sa); sb = wave_sum(sb);
        const float ra = rsqrtf(sa * (1.0f / 1024.0f) + EPS), rb = rsqrtf(sb * (1.0f / 1024.0f) + EPS);
#pragma unroll
        for (int i = 0; i < 2; ++i)
#pragma unroll
            for (int k = 0; k < 2; ++k) {
                const int col = i * 512 + lane * 8 + 4 * k;
                const f32x4 xx = *(const f32x4*)(p.x + grow * DM + col), ga = *(const f32x4*)(p.a_post + col), gb = *(const f32x4*)(p.b_post + col);
                f32x4 hh;
                hh.x = (xx.x + ya[8 * i + 4 * k] * ra * ga.x) + yb[8 * i + 4 * k] * rb * gb.x;
                hh.y = (xx.y + ya[8 * i + 4 * k + 1] * ra * ga.y) + yb[8 * i + 4 * k + 1] * rb * gb.y;
                hh.z = (xx.z + ya[8 * i + 4 * k + 2] * ra * ga.z) + yb[8 * i + 4 * k + 2] * rb * gb.z;
                hh.w = (xx.w + ya[8 * i + 4 * k + 3] * ra * ga.w) + yb[8 * i + 4 * k + 3] * rb * gb.w;
                *(f32x4*)(p.out + grow * DM + col) = hh;
            }
    }
}

__global__ void __launch_bounds__(512) yoco_fwd(KParams kp) {
    extern __shared__ __attribute__((aligned(16))) char dsm[];
    char* smem = dsm;
    uint4* xbw = (uint4*)(dsm + SMEM_BYTES);
    if (threadIdx.x == 0) *xbw = make_uint4(0u, 0u, 0u, 0u);
    __syncthreads();
    XcdBarrier bar = xcd_barrier_post(kp.bar, (volatile LAS unsigned*)xbw);
    if (kp.magic == 0x5eed1234) cg::this_grid().sync();

    {
        const Params p = derive(kp);
        transpose_all(p, smem);
    }
#define PH(call) do { const Params p = derive(kp); call; } while (0)
    for (int ch = 0; ch < kp.nchunks; ++ch) {
        const int b0 = ch * kp.CB;
        PH(phase_pre(p, b0));                                        xcd_barrier(bar);
        PH(phase_gemm_a_in(p, smem));                                xcd_barrier(bar);
        PH(phase_attn_a(p, smem));                                   xcd_barrier(bar);
        PH(phase_merge(p));                                          xcd_barrier(bar);
        PH(phase_gemm_plain(p, smem, p.hn0, p.WaoT, p.Za));          xcd_barrier(bar);
        PH(phase_post_a(p, b0));                                     xcd_barrier(bar);
        PH(phase_gemm_down(p, smem));                                xcd_barrier(bar);
        PH(phase_gemm_up(p, smem));                                  xcd_barrier(bar);
        PH(phase_attn_b(p, smem));                                   xcd_barrier(bar);
        PH(phase_gemm_plain(p, smem, p.y2, p.WboT, p.yB));           xcd_barrier(bar);
        PH(phase_final(p, b0));
    }
}

extern "C" void kernel_launch(void* const* d_in, const int* in_sizes, int n_in, void* d_out, int out_size, void* d_ws, size_t ws_size, hipStream_t stream) {
    (void)in_sizes; (void)n_in; (void)out_size;
    static int grid_blocks = 0;
    if (!grid_blocks) {
        int dev = 0, cus = 0, per_cu = 0;
        (void)hipGetDevice(&dev);
        (void)hipDeviceGetAttribute(&cus, hipDeviceAttributeMultiprocessorCount, dev);
        (void)hipFuncSetAttribute((const void*)yoco_fwd, hipFuncAttributeMaxDynamicSharedMemorySize, SMEM_BYTES + 16);
        (void)hipOccupancyMaxActiveBlocksPerMultiprocessor(&per_cu, yoco_fwd, NTHR, SMEM_BYTES + 16);
        if (per_cu > 1) per_cu = 1;
        if (per_cu < 1) per_cu = 1;
        grid_blocks = cus * per_cu;
    }
    KParams p{};
    p.x = (const float*)d_in[0]; p.pos = (const int*)d_in[1]; p.a_pre = (const float*)d_in[2]; p.a_w_in = (const float*)d_in[3];
    p.a_w_out = (const float*)d_in[4]; p.a_post = (const float*)d_in[5]; p.kv_norm = (const float*)d_in[6]; p.kv_w_down = (const float*)d_in[7];
    p.kv_lat = (const float*)d_in[8]; p.kv_w_up = (const float*)d_in[9]; p.b_pre = (const float*)d_in[10]; p.b_w_in = (const float*)d_in[11];
    p.b_qn = (const float*)d_in[12]; p.b_w_q_up = (const float*)d_in[13]; p.b_w_out = (const float*)d_in[14]; p.b_post = (const float*)d_in[15];
    p.out = (float*)d_out;
    char* base = (char*)d_ws;
    p.bar = (unsigned*)base;
    p.wbase = (bf16_t*)(base + 16384);
    const size_t wbytes = ((size_t)10240 * 1024 + 1024 * 1024 + 1792 * 1024 + 2048 * 256 + 1536 * 384 + 1024 * 1024) * 2;
    const size_t fixed = 16384 + wbytes;
    int CB = NBATCH;
    const size_t per_tok = 4 * 64 + 2048 + 2048 + 6144 + 96 + 18432;
    while (CB > 4 && fixed + (size_t)CB * 2048 * per_tok + 65536 > ws_size) CB >>= 1;
    const size_t NT = (size_t)CB * 2048;
    char* c = base + fixed;
    p.tbase = (float*)c; c += NT * 256;
    p.abase = (bf16_t*)c; c += NT * (2048 + 2048 + 6144 + 96);
    p.rbase = (bf16_t*)c;
    p.CB = CB; p.nchunks = NBATCH / CB; p.magic = 0; p.pad = 0;

    (void)hipMemsetAsync(p.bar, 0, 16384, stream);
    void* args[] = {&p};
    hipError_t e = hipLaunchCooperativeKernel((void*)yoco_fwd, dim3(grid_blocks), dim3(NTHR), args, SMEM_BYTES + 16, stream);
    if (e != hipSuccess) fprintf(stderr, "cooperative launch failed: %s (grid %d)\n", hipGetErrorString(e), grid_blocks);
}
```
